# Optimizing an MI355X kernel written in HIP

```python
import math
import jax, jax.numpy as jnp
from jax import lax
import numpy as np

D_MODEL = 1024
BATCH = 8
SEQ = 8192
DEPTH = 1

CHUNK = 64
GMLP_BLOCK = 128
GMLP_WIDTH = D_MODEL
GMLP_GROUPS = 8
GMLP_GROUP_DIM = GMLP_WIDTH // GMLP_GROUPS
DIFF_HEAD_DIM = 64
DIFF_HEADS = D_MODEL // (2 * DIFF_HEAD_DIM)
DIFF_QK_WIDTH = DIFF_HEADS * 2 * DIFF_HEAD_DIM
DIFF_V_WIDTH = DIFF_HEADS * 2 * DIFF_HEAD_DIM
FF_WIDTH = 4 * D_MODEL
PLE_DIM = 256
ROPE_THETA = 10000.0
Q_BLOCK = 128
EPS = 1e-6

IN_WIDTHS = (GMLP_WIDTH, GMLP_WIDTH, DIFF_QK_WIDTH, DIFF_QK_WIDTH, DIFF_V_WIDTH, D_MODEL, D_MODEL)
IN_WIDTH = sum(IN_WIDTHS)
IN_SPLITS = tuple(int(v) for v in np.cumsum(IN_WIDTHS)[:-1])

kernel_name = "hybrid_gmlp_diffattn_block"


def rms_norm(x, gain):
    xf = x.astype(jnp.float32)
    y = xf * lax.rsqrt(jnp.mean(xf * xf, axis=-1, keepdims=True) + EPS)
    return (y * gain.astype(jnp.float32)).astype(x.dtype)


def layer_norm(x, gain, bias):
    xf = x.astype(jnp.float32)
    mu = jnp.mean(xf, axis=-1, keepdims=True)
    var = jnp.mean(jnp.square(xf - mu), axis=-1, keepdims=True)
    y = (xf - mu) * lax.rsqrt(var + EPS)
    return (y * gain.astype(jnp.float32) + bias.astype(jnp.float32)).astype(x.dtype)


def rope_tables(seq):
    pos = jnp.arange(seq, dtype=jnp.float32)
    inv = 1.0 / (ROPE_THETA ** (jnp.arange(0, DIFF_HEAD_DIM, 2, dtype=jnp.float32) / DIFF_HEAD_DIM))
    ang = pos[:, None] * inv[None, :]
    ang = jnp.concatenate([ang, ang], axis=-1)
    return jnp.cos(ang), jnp.sin(ang)


def apply_rope(t, cos, sin):
    tf = t.astype(jnp.float32)
    half = DIFF_HEAD_DIM // 2
    rot = jnp.concatenate([-tf[..., half:], tf[..., :half]], axis=-1)
    c = cos[None, :, None, None, :]
    s = sin[None, :, None, None, :]
    return (tf * c + rot * s).astype(t.dtype)


def gmlp_spatial_gate(u, v, ln_g, ln_b, w_s, b_s):
    B, S, _ = v.shape
    vn = layer_norm(v, ln_g, ln_b)
    vb = vn.reshape(B, S // GMLP_BLOCK, GMLP_BLOCK, GMLP_GROUPS, GMLP_GROUP_DIM)
    t_chunk = jnp.arange(GMLP_BLOCK) // CHUNK
    allowed = t_chunk[None, :] <= t_chunk[:, None]
    w = jnp.where(allowed[None], w_s, jnp.zeros_like(w_s))
    mixed = jnp.einsum('gts,bnsgc->bntgc', w, vb) + b_s.T[None, None, :, :, None]
    return u * mixed.reshape(B, S, GMLP_WIDTH)


def diff_attention(q, k, v, lam):
    B, S, H, _, Dh = q.shape
    nb = S // Q_BLOCK
    qs = (q * (Dh ** -0.5)).reshape(B, nb, Q_BLOCK, H, 2, Dh).transpose(1, 0, 2, 3, 4, 5)
    key_chunk = jnp.arange(S) // CHUNK

    def one_block(args):
        i, qb = args
        q_chunk = (i * Q_BLOCK + jnp.arange(Q_BLOCK)) // CHUNK
        allowed = key_chunk[None, :] <= q_chunk[:, None]
        s = jnp.einsum('bqhcd,bkhcd->bhcqk', qb, k).astype(jnp.float32)
        s = jnp.where(allowed, s, -jnp.inf)
        pr = jax.nn.softmax(s, axis=-1)
        a = pr[:, :, 0] - lam * pr[:, :, 1]
        return jnp.einsum('bhqk,bkhe->bqhe', a.astype(v.dtype), v)

    out = lax.map(one_block, (jnp.arange(nb), qs))
    return out.transpose(1, 0, 2, 3, 4).reshape(B, S, H, 2 * Dh)


def setup_inputs(seed: int = 0) -> dict:
    key = jax.random.key(seed)
    ks = jax.random.split(key, 26)
    f32 = jnp.float32

    def nrm(k, shape, scale):
        return jax.random.normal(k, shape, f32) * scale

    def gain(k, n):
        return 1.0 + 0.05 * jax.random.normal(k, (DEPTH, n), f32)

    return {
        "x": nrm(ks[0], (BATCH, SEQ, D_MODEL), 1.0),
        "p": nrm(ks[1], (DEPTH, BATCH, SEQ, PLE_DIM), 1.0),
        "norm_pre_mix": gain(ks[2], D_MODEL),
        "w_in": nrm(ks[3], (DEPTH, D_MODEL, IN_WIDTH), D_MODEL ** -0.5),
        "ln_v_gain": gain(ks[4], GMLP_WIDTH),
        "ln_v_bias": nrm(ks[5], (DEPTH, GMLP_WIDTH), 0.02),
        "w_spatial": nrm(ks[6], (DEPTH, GMLP_GROUPS, GMLP_BLOCK, GMLP_BLOCK), 0.5 * GMLP_BLOCK ** -0.5),
        "b_spatial": 1.0 + nrm(ks[7], (DEPTH, GMLP_GROUPS, GMLP_BLOCK), 0.1),
        "lambda_q1": nrm(ks[8], (DEPTH, DIFF_HEAD_DIM), 0.1),
        "lambda_k1": nrm(ks[9], (DEPTH, DIFF_HEAD_DIM), 0.1),
        "lambda_q2": nrm(ks[10], (DEPTH, DIFF_HEAD_DIM), 0.1),
        "lambda_k2": nrm(ks[11], (DEPTH, DIFF_HEAD_DIM), 0.1),
        "subln_gain": gain(ks[12], 2 * DIFF_HEAD_DIM),
        "w_branch_a": nrm(ks[13], (DEPTH, GMLP_WIDTH, D_MODEL), GMLP_WIDTH ** -0.5),
        "w_branch_b": nrm(ks[14], (DEPTH, DIFF_V_WIDTH, D_MODEL), DIFF_V_WIDTH ** -0.5),
        "w_out": nrm(ks[15], (DEPTH, D_MODEL, D_MODEL), D_MODEL ** -0.5),
        "norm_post_mix": gain(ks[16], D_MODEL),
        "norm_pre_ffn": gain(ks[17], D_MODEL),
        "w_ff1": nrm(ks[18], (DEPTH, D_MODEL, FF_WIDTH), D_MODEL ** -0.5),
        "w_ff2": nrm(ks[19], (DEPTH, FF_WIDTH, D_MODEL), FF_WIDTH ** -0.5),
        "norm_post_ffn": gain(ks[20], D_MODEL),
        "w_ple_proj": nrm(ks[21], (DEPTH, PLE_DIM, D_MODEL), PLE_DIM ** -0.5),
        "w_ple_gate": nrm(ks[22], (DEPTH, D_MODEL, D_MODEL), D_MODEL ** -0.5),
        "b_ple_gate": nrm(ks[23], (DEPTH, D_MODEL), 0.02),
        "norm_post_ple": gain(ks[24], D_MODEL),
    }


def reference(x, p, norm_pre_mix, w_in, ln_v_gain, ln_v_bias, w_spatial, b_spatial,
              lambda_q1, lambda_k1, lambda_q2, lambda_k2, subln_gain,
              w_branch_a, w_branch_b, w_out, norm_post_mix, norm_pre_ffn,
              w_ff1, w_ff2, norm_post_ffn, w_ple_proj, w_ple_gate, b_ple_gate,
              norm_post_ple):
    B, S, _ = x.shape
    cos, sin = rope_tables(S)
    h = x
    for i in range(DEPTH):
        n = rms_norm(h, norm_pre_mix[i])
        z = n @ w_in[i]
        u, v, q, k, va, ga, gb = jnp.split(z, IN_SPLITS, axis=-1)

        ya = gmlp_spatial_gate(jax.nn.gelu(u), jax.nn.gelu(v), ln_v_gain[i], ln_v_bias[i],
                               w_spatial[i], b_spatial[i])

        q = apply_rope(q.reshape(B, S, DIFF_HEADS, 2, DIFF_HEAD_DIM), cos, sin)
        k = apply_rope(k.reshape(B, S, DIFF_HEADS, 2, DIFF_HEAD_DIM), cos, sin)
        va = va.reshape(B, S, DIFF_HEADS, 2 * DIFF_HEAD_DIM)
        lambda_init = 0.8 - 0.6 * math.exp(-0.3 * i)
        lam = (jnp.exp(jnp.sum(lambda_q1[i].astype(jnp.float32) * lambda_k1[i].astype(jnp.float32)))
               - jnp.exp(jnp.sum(lambda_q2[i].astype(jnp.float32) * lambda_k2[i].astype(jnp.float32)))
               + lambda_init)
        o = diff_attention(q, k, va, lam)
        o = rms_norm(o, subln_gain[i]) * (1.0 - lambda_init)
        yb = o.reshape(B, S, DIFF_V_WIDTH)

        merged = jax.nn.sigmoid(ga) * (ya @ w_branch_a[i]) + jax.nn.sigmoid(gb) * (yb @ w_branch_b[i])
        h = h + rms_norm(merged @ w_out[i], norm_post_mix[i])

        f = rms_norm(h, norm_pre_ffn[i]) @ w_ff1[i]
        f = jnp.square(jax.nn.relu(f)) @ w_ff2[i]
        h = h + rms_norm(f, norm_post_ffn[i])

        e = (p[i] @ w_ple_proj[i]) * jax.nn.sigmoid(h @ w_ple_gate[i] + b_ple_gate[i])
        h = h + rms_norm(e, norm_post_ple[i])
    return h
```

```cpp
#include <hip/hip_runtime.h>
#include <hip/hip_cooperative_groups.h>
#include <cstdio>
namespace cg = cooperative_groups;

#define LAS __attribute__((address_space(3)))
#define DI __device__ __forceinline__
typedef unsigned short bf16_t;
typedef short bf16x8 __attribute__((ext_vector_type(8)));
typedef float f32x4 __attribute__((ext_vector_type(4)));
typedef float f32x16 __attribute__((ext_vector_type(16)));
typedef unsigned u32x4 __attribute__((ext_vector_type(4)));
typedef unsigned u32x2 __attribute__((ext_vector_type(2)));

constexpr int MT = 65536, DM = 1024, SEQ = 8192, FFW = 4096, PLED = 256;
constexpr float EPSV = 1e-6f;
constexpr size_t SLOT = (size_t)1 << 27;
constexpr size_t OFF_WIN = 0;
constexpr size_t OFF_WVA = OFF_WIN + (size_t)6144 * 1024 * 2;
constexpr size_t OFF_WA = OFF_WVA + (size_t)1024 * 1024 * 2;
constexpr size_t OFF_WB = OFF_WA + (size_t)1024 * 1024 * 2;
constexpr size_t OFF_WO = OFF_WB + (size_t)1024 * 1024 * 2;
constexpr size_t OFF_WF1 = OFF_WO + (size_t)1024 * 1024 * 2;
constexpr size_t OFF_WF2 = OFF_WF1 + (size_t)4096 * 1024 * 2;
constexpr size_t OFF_WP = OFF_WF2 + (size_t)4096 * 1024 * 2;
constexpr size_t OFF_WG = OFF_WP + (size_t)1024 * 256 * 2;
constexpr size_t OFF_ROPE = OFF_WG + (size_t)1024 * 1024 * 2;
constexpr size_t OFF_SS = OFF_ROPE + (size_t)8192 * 32 * 8;
constexpr size_t OFF_WS = OFF_SS + (size_t)3 * 65536 * 4;
constexpr size_t OFF_PB = OFF_WS + (size_t)8 * 128 * 128 * 2;
constexpr size_t OFF_END = OFF_PB + (size_t)65536 * 256 * 2;
constexpr size_t OFF_BAR = OFF_END;
static_assert(OFF_BAR + 16384 <= SLOT, "misc region overflow");

constexpr int LDS_BYTES = 131072 + 16;
constexpr int NPHASE = 11;
#ifndef STAGGER_TICKS
#define STAGGER_TICKS 700
#endif
#ifndef PHMASK
#define PHMASK 31
#endif

struct Params {
    const float* in[25];
    float* out;
    unsigned char* ws;
    int ph_lo, ph_hi;
};

typedef __bf16 bf16x2n __attribute__((ext_vector_type(2)));
typedef float f32x2n __attribute__((ext_vector_type(2)));
DI unsigned cvt_pk_bf16(float lo, float hi) { const f32x2n v = {lo, hi}; return __builtin_bit_cast(unsigned, __builtin_convertvector(v, bf16x2n)); }
DI float bf_lo(unsigned w) { return __uint_as_float(w << 16); }
DI float bf_hi(unsigned w) { return __uint_as_float(w & 0xffff0000u); }
DI float fast_exp2(float x) { return __builtin_amdgcn_exp2f(x); }
DI float fast_rcp(float x) { return __builtin_amdgcn_rcpf(x); }
DI float sigmoid_f(float x) { return fast_rcp(1.0f + fast_exp2(-1.4426950408889634f * x)); }
DI float gelu_tanh(float x) { const float u = x * (0.7978845608028654f + 0.035677408136300125f * x * x); return x * fast_rcp(1.0f + fast_exp2(-2.885390081777927f * u)); }
DI int opaque_tid() { int t = threadIdx.x; asm volatile("" : "+v"(t)); return t; }
DI float xhalf_max(float x) { const auto r = __builtin_amdgcn_permlane32_swap(__float_as_uint(x), __float_as_uint(x), false, false); return fmaxf(__uint_as_float(r[0]), __uint_as_float(r[1])); }
DI float wave_sum(float v) { v += __shfl_xor(v, 32); v += __shfl_xor(v, 16); v += __shfl_xor(v, 8); v += __shfl_xor(v, 4); v += __shfl_xor(v, 2); v += __shfl_xor(v, 1); return v; }

constexpr int BM = 256, BK = 64, HALF = 128, HTB = HALF * BK * 2, NXCD = 8, WGM = 8;
DI int lds_byte(int r, int c) { const int st = (r >> 4) * 2 + (c >> 5), rr = r & 15, cc = c & 31, ob = rr * 64 + cc * 2; return st * 1024 + (ob ^ (((ob >> 9) & 1) << 5)); }
DI void stage_rc(int b, int& R, int& C) { const int st = b / 1024, sb = b % 1024, swz = sb ^ (((sb >> 9) & 1) << 5); R = (st >> 1) * 16 + swz / 64; C = (st & 1) * 32 + (swz % 64) / 2; }
DI int perm32(int rho) { const int n = rho >> 4, i = rho & 15; return 8 * (i >> 2) + 4 * n + (i & 3); }
struct Unit { int pm, pn; };
struct StaticOrder {
    int nM, nN, nwg, G, c;
    DI void init(int M, int N, int G_, int c_) { nM = M / BM; nN = N / BM; nwg = nM * nN; G = G_; c = c_; }
    DI bool next(int i, Unit& u) const {
        const long L = (long)i * G + c; if (L >= nwg) return false;
        int wgid = (int)L; { const int q = nwg / NXCD, r = nwg % NXCD, xcd = wgid % NXCD, off = wgid / NXCD; wgid = (xcd < r ? xcd * (q + 1) : r * (q + 1) + (xcd - r) * q) + off; }
        const int nig = WGM * nN, gid = wgid / nig, fm = gid * WGM, gsz = (nM - fm) < WGM ? (nM - fm) : WGM;
        u.pm = fm + ((wgid % nig) % gsz); u.pn = (wgid % nig) / gsz; return true;
    }
};

enum { EPI_IN = 0, EPI_BF16 = 1, EPI_BRA = 2, EPI_BRB = 3, EPI_RAW = 4, EPI_RELU2 = 5, EPI_GATE = 6, EPI_VT = 7 };
struct GemmJob {
    const bf16_t* A; const bf16_t* Bt; int M, N, K; int mode;
    bf16_t* o0; int ldc;
    const bf16_t* i0;
    float* fo; float* ss; const float* bias;
    bf16_t* in_base;
    bf16_t* gb_base;
    const float* rope;
};

constexpr float QSCALE = 0.125f * 1.4426950408889634f;

DI void epilogue(const f32x4 (&acc)[2][2][4][2], const Unit& u, int wr, int wc, int fr, int fq, const GemmJob& J) {
    const int mode = J.mode;
    if (mode == EPI_IN) {
        const int region = u.pn >> 2;
        bf16_t* base = region == 0 ? J.in_base : region == 1 ? J.in_base + (SLOT / 2) : region == 2 ? J.in_base + 2 * (SLOT / 2) : region == 3 ? J.in_base + 3 * (SLOT / 2)
                     : region == 4 ? J.in_base + 5 * (SLOT / 2) : J.gb_base;
        const int row0 = u.pm * BM + wr * 64 + fr, col0 = (u.pn & 3) * BM + wc * 32 + 8 * fq;
#pragma unroll
        for (int ai = 0; ai < 2; ++ai)
#pragma unroll
            for (int m = 0; m < 4; ++m) {
                const int row = row0 + ai * HALF + m * 16;
                bf16_t* rowp = base + (size_t)row * DM + col0;
                f32x4 t0 = {1.f, 0.f, 1.f, 0.f}, t1 = {1.f, 0.f, 1.f, 0.f};
                if (region == 2 || region == 3) {
                    const float* tp = J.rope + ((size_t)(row & (SEQ - 1)) * 32 + 16 * (wc & 1) + 4 * fq) * 2;
                    t0 = *(const f32x4*)tp; t1 = *(const f32x4*)(tp + 4);
                }
#pragma unroll
                for (int bj = 0; bj < 2; ++bj) {
                    f32x4 v0 = acc[ai][bj][m][0], v1 = acc[ai][bj][m][1];
                    if (region < 2) {
#pragma unroll
                        for (int j = 0; j < 4; ++j) { v0[j] = gelu_tanh(v0[j]); v1[j] = gelu_tanh(v1[j]); }
                    } else if (region < 4) {
                        const float sc = region == 2 ? QSCALE : 1.0f;
                        f32x4 a, b;
                        a[0] = (v0[0] * t0[0] - v0[1] * t0[1]) * sc; a[1] = (v0[1] * t0[0] + v0[0] * t0[1]) * sc;
                        a[2] = (v0[2] * t0[2] - v0[3] * t0[3]) * sc; a[3] = (v0[3] * t0[2] + v0[2] * t0[3]) * sc;
                        b[0] = (v1[0] * t1[0] - v1[1] * t1[1]) * sc; b[1] = (v1[1] * t1[0] + v1[0] * t1[1]) * sc;
                        b[2] = (v1[2] * t1[2] - v1[3] * t1[3]) * sc; b[3] = (v1[3] * t1[2] + v1[2] * t1[3]) * sc;
                        v0 = a; v1 = b;
                    } else {
#pragma unroll
                        for (int j = 0; j < 4; ++j) { v0[j] = sigmoid_f(v0[j]); v1[j] = sigmoid_f(v1[j]); }
                    }
                    u32x4 w; w.x = cvt_pk_bf16(v0[0], v0[1]); w.y = cvt_pk_bf16(v0[2], v0[3]); w.z = cvt_pk_bf16(v1[0], v1[1]); w.w = cvt_pk_bf16(v1[2], v1[3]);
                    if (region == 3) {
                        const size_t ko = ((size_t)((row >> 13) * 8 + (u.pn & 3) * 2 + bj) * SEQ + (row & (SEQ - 1))) * 128 + wc * 32 + 8 * fq;
                        *(u32x4*)(base + ko) = w;
                    } else *(u32x4*)(rowp + bj * HALF) = w;
                }
            }
    } else if (mode == EPI_BF16 || mode == EPI_RELU2 || mode == EPI_BRA || mode == EPI_BRB || mode == EPI_VT) {
        const bool widem = (mode == EPI_BRA || mode == EPI_BRB);
        const int wcs = widem ? 64 : 32, bjs = widem ? 32 : HALF;
        const int row0 = u.pm * BM + wr * 64 + fr, col0 = u.pn * BM + wc * wcs + 8 * fq;
#pragma unroll
        for (int ai = 0; ai < 2; ++ai)
#pragma unroll
            for (int m = 0; m < 4; ++m) {
                const size_t off = (size_t)(row0 + ai * HALF + m * 16) * J.ldc + col0;
#pragma unroll
                for (int bj = 0; bj < 2; ++bj) {
                    f32x4 v0 = acc[ai][bj][m][0], v1 = acc[ai][bj][m][1];
                    if (mode == EPI_RELU2) {
#pragma unroll
                        for (int j = 0; j < 4; ++j) { const float a = fmaxf(v0[j], 0.f), b = fmaxf(v1[j], 0.f); v0[j] = a * a; v1[j] = b * b; }
                    } else if (mode == EPI_BRA || mode == EPI_BRB) {
                        const u32x4 g = *(const u32x4*)(J.o0 + off + bj * bjs);
                        v0[0] *= bf_lo(g.x); v0[1] *= bf_hi(g.x); v0[2] *= bf_lo(g.y); v0[3] *= bf_hi(g.y);
                        v1[0] *= bf_lo(g.z); v1[1] *= bf_hi(g.z); v1[2] *= bf_lo(g.w); v1[3] *= bf_hi(g.w);
                        if (mode == EPI_BRB) {
                            const u32x4 t = *(const u32x4*)(J.i0 + off + bj * bjs);
                            v0[0] += bf_lo(t.x); v0[1] += bf_hi(t.x); v0[2] += bf_lo(t.y); v0[3] += bf_hi(t.y);
                            v1[0] += bf_lo(t.z); v1[1] += bf_hi(t.z); v1[2] += bf_lo(t.w); v1[3] += bf_hi(t.w);
                        }
                    }
                    u32x4 w; w.x = cvt_pk_bf16(v0[0], v0[1]); w.y = cvt_pk_bf16(v0[2], v0[3]); w.z = cvt_pk_bf16(v1[0], v1[1]); w.w = cvt_pk_bf16(v1[2], v1[3]);
                    if (mode == EPI_VT) {
                        const int feat = row0 + ai * HALF + m * 16, tok = col0 + bj * bjs;
                        const size_t vo = ((((size_t)((tok >> 13) * 8 + (feat >> 7)) * 128 + ((tok & (SEQ - 1)) >> 6)) * 128 + (feat & 127)) * 64) + (tok & 63);
                        *(u32x4*)(J.o0 + vo) = w;
                    } else
                    *(u32x4*)(J.o0 + off + bj * bjs) = w;
                }
            }
    } else {
        const int row0 = u.pm * BM + wr * 64 + fr, col0 = u.pn * BM + wc * 64 + 8 * fq;
#pragma unroll
        for (int ai = 0; ai < 2; ++ai)
#pragma unroll
            for (int m = 0; m < 4; ++m) {
                const int row = row0 + ai * HALF + m * 16;
                const size_t off = (size_t)row * DM + col0;
                float s = 0.f;
#pragma unroll
                for (int bj = 0; bj < 2; ++bj) {
                    f32x4 v0 = acc[ai][bj][m][0], v1 = acc[ai][bj][m][1];
                    if (mode == EPI_GATE) {
                        const f32x4 b0 = *(const f32x4*)(J.bias + col0 + bj * 32), b1 = *(const f32x4*)(J.bias + col0 + bj * 32 + 4);
                        const u32x4 e = *(const u32x4*)(J.i0 + off + bj * 32);
                        v0[0] = bf_lo(e.x) * sigmoid_f(v0[0] + b0[0]); v0[1] = bf_hi(e.x) * sigmoid_f(v0[1] + b0[1]);
                        v0[2] = bf_lo(e.y) * sigmoid_f(v0[2] + b0[2]); v0[3] = bf_hi(e.y) * sigmoid_f(v0[3] + b0[3]);
                        v1[0] = bf_lo(e.z) * sigmoid_f(v1[0] + b1[0]); v1[1] = bf_hi(e.z) * sigmoid_f(v1[1] + b1[1]);
                        v1[2] = bf_lo(e.w) * sigmoid_f(v1[2] + b1[2]); v1[3] = bf_hi(e.w) * sigmoid_f(v1[3] + b1[3]);
                    }
                    u32x4 w; w.x = cvt_pk_bf16(v0[0], v0[1]); w.y = cvt_pk_bf16(v0[2], v0[3]); w.z = cvt_pk_bf16(v1[0], v1[1]); w.w = cvt_pk_bf16(v1[2], v1[3]);
                    *(u32x4*)((bf16_t*)J.fo + off + bj * 32) = w;
                    s += ((v0[0] * v0[0] + v0[1] * v0[1]) + (v0[2] * v0[2] + v0[3] * v0[3])) + ((v1[0] * v1[0] + v1[1] * v1[1]) + (v1[2] * v1[2] + v1[3] * v1[3]));
                }
                s += __shfl_xor(s, 16); s += __shfl_xor(s, 32);
                if (fq == 0) atomicAdd(J.ss + row, s);
            }
    }
}

DI void gemm_phase(LAS unsigned char* lds, const GemmJob& J, int G, int cidx) {
    const int tid = opaque_tid(), wid = __builtin_amdgcn_readfirstlane(tid >> 6), lane = tid & 63, wr = wid >> 2, wc = wid & 3, fr = lane & 15, fq = lane >> 4;
    const int K = J.K, nt = K / BK;
    const bool perm = true;
    const bool wide = (J.mode == EPI_BRA || J.mode == EPI_BRB || J.mode == EPI_RAW || J.mode == EPI_GATE);
    StaticOrder S; S.init(J.M, J.N, G, cidx);
    unsigned voffA[2], voffB[2];
#pragma unroll
    for (int i = 0; i < 2; ++i) { int R, C; stage_rc(tid * 16 + i * 8192, R, C); const int Rb = perm ? ((R & ~31) + perm32(R & 31)) : R;
        const int Rw = 64 * (R >> 5) + perm32(R & 31);
        voffA[i] = (unsigned)(R * K + C) * 2u; voffB[i] = (unsigned)((wide ? Rw : Rb) * K + C) * 2u; }
    const size_t kstep = (size_t)(BK * 2);
    const size_t hstep = (size_t)HALF * K * 2;
    const size_t tstep = 2 * hstep;
    const size_t hstepB = wide ? (size_t)32 * K * 2 : hstep;
    const unsigned ldsw = (unsigned)wid * 1024u;
    const int aoff = lds_byte(wr * 64 + fr, fq * 8), boff = lds_byte(wc * 32 + fr, fq * 8);
#define PG8_SA(b, h) (((b) * 2 + (h)) * HTB)
#define PG8_SB(b, h) ((4 + (b) * 2 + (h)) * HTB)
#define PG8_STAGE(bufoff, gbase, voff) do { _Pragma("unroll") for (int _i = 0; _i < 2; ++_i) \
        __builtin_amdgcn_global_load_lds((const unsigned*)((const char*)(gbase) + (voff)[_i]), (LAS unsigned*)(lds + (bufoff) + ldsw + _i * 8192), 16, 0, 0); } while (0)
#define PG8_LDA(dst, b, h) do { _Pragma("unroll") for (int m = 0; m < 4; ++m) _Pragma("unroll") for (int k = 0; k < 2; ++k) dst[m][k] = *(const LAS bf16x8*)(lds + PG8_SA(b, h) + aoff + m * 2048 + k * 1024); } while (0)
#define PG8_LDB(dst, b, h) do { _Pragma("unroll") for (int n = 0; n < 2; ++n) _Pragma("unroll") for (int k = 0; k < 2; ++k) dst[n][k] = *(const LAS bf16x8*)(lds + PG8_SB(b, h) + boff + n * 2048 + k * 1024); } while (0)
#define PG8_MMA(ai, bj, At, Bt) do { __builtin_amdgcn_s_setprio(1); _Pragma("unroll") for (int m = 0; m < 4; ++m) _Pragma("unroll") for (int n = 0; n < 2; ++n) _Pragma("unroll") for (int k = 0; k < 2; ++k) \
        acc[ai][bj][m][n] = __builtin_amdgcn_mfma_f32_16x16x32_bf16(Bt[n][k], At[m][k], acc[ai][bj][m][n], 0, 0, 0); __builtin_amdgcn_s_setprio(0); } while (0)
#define PG8_WAIT_V(n) asm volatile("s_waitcnt vmcnt(" #n ")" ::: "memory")
#define PG8_WAIT_L(n) asm volatile("s_waitcnt lgkmcnt(" #n ")" ::: "memory")
#define PG8_BAR __builtin_amdgcn_s_barrier()
#define PG8_SCHED __builtin_amdgcn_sched_barrier(0)
    Unit cur, nxt; int ui = 0;
    if (!S.next(0, cur)) return;
    f32x4 acc[2][2][4][2];
#pragma unroll
    for (int a = 0; a < 2; ++a)
#pragma unroll
        for (int b = 0; b < 2; ++b)
#pragma unroll
            for (int m = 0; m < 4; ++m)
#pragma unroll
                for (int n = 0; n < 2; ++n) acc[a][b][m][n] = (f32x4){0.f, 0.f, 0.f, 0.f};
    bf16x8 At[4][2], B0[2][2], B1[2][2];
    const char* cA = (const char*)J.A + (size_t)cur.pm * tstep; const char* cB = (const char*)J.Bt + (size_t)cur.pn * tstep;
    PG8_STAGE(PG8_SB(0, 0), cB, voffB); PG8_STAGE(PG8_SA(0, 0), cA, voffA); PG8_STAGE(PG8_SB(0, 1), cB + hstepB, voffB); PG8_STAGE(PG8_SA(0, 1), cA + hstep, voffA);
    if (wr == 1) PG8_BAR;
    PG8_WAIT_V(4); PG8_BAR;
    PG8_STAGE(PG8_SB(1, 0), cB + kstep, voffB); PG8_STAGE(PG8_SA(1, 0), cA + kstep, voffA); PG8_STAGE(PG8_SB(1, 1), cB + hstepB + kstep, voffB);
    PG8_WAIT_V(6); PG8_BAR;
    for (;;) {
        const bool has_next = S.next(ui + 1, nxt);
        const char* nA = has_next ? (const char*)J.A + (size_t)nxt.pm * tstep : cA; const char* nB = has_next ? (const char*)J.Bt + (size_t)nxt.pn * tstep : cB;
        for (int t = 0; t < nt; t += 2) {
            const bool last = (t == nt - 2);
            const char* a1 = cA + (size_t)(t + 1) * kstep;
            const char* a2 = last ? nA : cA + (size_t)(t + 2) * kstep; const char* b2 = last ? nB : cB + (size_t)(t + 2) * kstep;
            const char* a3 = a2 + kstep; const char* b3 = b2 + kstep;
            PG8_LDB(B0, 0, 0); PG8_SCHED; PG8_LDA(At, 0, 0); PG8_STAGE(PG8_SA(1, 1), a1 + hstep, voffA);
            PG8_WAIT_L(8); PG8_BAR; PG8_WAIT_L(0); PG8_MMA(0, 0, At, B0); PG8_BAR; PG8_SCHED;
            PG8_LDB(B1, 0, 1); PG8_STAGE(PG8_SB(0, 0), b2, voffB);
            PG8_BAR; PG8_WAIT_L(0); PG8_MMA(0, 1, At, B1); PG8_BAR;
            PG8_LDA(At, 0, 1); PG8_STAGE(PG8_SA(0, 0), a2, voffA);
            PG8_BAR; PG8_WAIT_L(0); PG8_MMA(1, 0, At, B0); PG8_BAR; PG8_SCHED;
            PG8_STAGE(PG8_SB(0, 1), b2 + hstepB, voffB);
            PG8_WAIT_V(6); PG8_BAR; PG8_MMA(1, 1, At, B1); PG8_BAR;
            PG8_LDB(B0, 1, 0); PG8_SCHED; PG8_LDA(At, 1, 0); PG8_STAGE(PG8_SA(0, 1), a2 + hstep, voffA);
            PG8_WAIT_L(8); PG8_BAR; PG8_WAIT_L(0); PG8_MMA(0, 0, At, B0); PG8_BAR; PG8_SCHED;
            PG8_LDB(B1, 1, 1); PG8_STAGE(PG8_SB(1, 0), b3, voffB);
            PG8_BAR; PG8_WAIT_L(0); PG8_MMA(0, 1, At, B1); PG8_BAR;
            PG8_LDA(At, 1, 1); PG8_STAGE(PG8_SA(1, 0), a3, voffA);
            PG8_BAR; PG8_WAIT_L(0); PG8_MMA(1, 0, At, B0); PG8_BAR; PG8_SCHED;
            PG8_STAGE(PG8_SB(1, 1), b3 + hstepB, voffB);
            PG8_WAIT_V(6); PG8_BAR; PG8_MMA(1, 1, At, B1); PG8_BAR;
        }
        epilogue(acc, cur, wr, wc, fr, fq, J);
        if (!has_next) break;
#pragma unroll
        for (int a = 0; a < 2; ++a)
#pragma unroll
            for (int b = 0; b < 2; ++b)
#pragma unroll
                for (int m = 0; m < 4; ++m)
#pragma unroll
                    for (int n = 0; n < 2; ++n) acc[a][b][m][n] = (f32x4){0.f, 0.f, 0.f, 0.f};
        cur = nxt; cA = nA; cB = nB; ++ui;
    }
    PG8_WAIT_V(0);
    if (wr == 0) PG8_BAR;
    PG8_BAR;
#undef PG8_SA
#undef PG8_SB
#undef PG8_STAGE
#undef PG8_LDA
#undef PG8_LDB
#undef PG8_MMA
#undef PG8_WAIT_V
#undef PG8_WAIT_L
#undef PG8_BAR
#undef PG8_SCHED
}

DI bf16_t* win_dstrow(int sc, bf16_t* win_t, bf16_t* wva_t) {
    if (sc < 2048) return win_t + (size_t)sc * DM;
    if (sc < 4096) { const int g = sc & ~63, d = sc & 63, p = ((d & 31) << 1) | (d >> 5); return win_t + (size_t)(g + p) * DM; }
    if (sc < 5120) return wva_t + (size_t)(sc - 4096) * DM;
    return win_t + (size_t)(sc - 1024) * DM;
}
struct TJob { const float* src; int Kdim, Ncols, tk, tn, mode; bf16_t* dst; bf16_t* dst2; };
DI TJob tjob(const Params& P, unsigned char* misc, int t) {
    TJob j; j.mode = 0; j.dst2 = nullptr;
    if (t < 1792) { j.src = P.in[3]; j.Kdim = 1024; j.Ncols = 7168; j.tk = t / 112; j.tn = t % 112; j.mode = 1; j.dst = (bf16_t*)(misc + OFF_WIN); j.dst2 = (bf16_t*)(misc + OFF_WVA); }
    else if (t < 2560) { const int q = t - 1792, w = q >> 8, tt = q & 255; j.src = w == 0 ? P.in[13] : w == 1 ? P.in[14] : P.in[15];
        j.dst = (bf16_t*)(misc + (w == 0 ? OFF_WA : w == 1 ? OFF_WB : OFF_WO)); j.Kdim = 1024; j.Ncols = 1024; j.tk = tt >> 4; j.tn = tt & 15; }
    else if (t < 3584) { const int q = t - 2560; j.src = P.in[18]; j.Kdim = 1024; j.Ncols = 4096; j.tk = q >> 6; j.tn = q & 63; j.dst = (bf16_t*)(misc + OFF_WF1); }
    else if (t < 4608) { const int q = t - 3584; j.src = P.in[19]; j.Kdim = 4096; j.Ncols = 1024; j.tk = q >> 4; j.tn = q & 15; j.dst = (bf16_t*)(misc + OFF_WF2); }
    else if (t < 4672) { const int q = t - 4608; j.src = P.in[21]; j.Kdim = 256; j.Ncols = 1024; j.tk = q >> 4; j.tn = q & 15; j.dst = (bf16_t*)(misc + OFF_WP); }
    else { const int q = t - 4672; j.src = P.in[22]; j.Kdim = 1024; j.Ncols = 1024; j.tk = q >> 4; j.tn = q & 15; j.dst = (bf16_t*)(misc + OFF_WG); }
    return j;
}
DI void tconv_load(const TJob& j, int tid, f32x4 (&v)[2]) {
    const int c4 = (tid & 15) * 4, r = tid >> 4;
#pragma unroll
    for (int i = 0; i < 2; ++i) v[i] = *(const f32x4*)(j.src + (size_t)(j.tk * 64 + r + 32 * i) * j.Ncols + j.tn * 64 + c4);
}
DI void tconv_finish(LAS float* tile, const TJob& j, int tid, const f32x4 (&v)[2]) {
    const int k0 = j.tk * 64, c0 = j.tn * 64;
    {
        const int c4 = (tid & 15) * 4, r = tid >> 4;
#pragma unroll
        for (int i = 0; i < 2; ++i) {
            const int rr = r + 32 * i;
            tile[(c4 + 0) * 65 + rr] = v[i][0]; tile[(c4 + 1) * 65 + rr] = v[i][1]; tile[(c4 + 2) * 65 + rr] = v[i][2]; tile[(c4 + 3) * 65 + rr] = v[i][3];
        }
    }
    __syncthreads();
    {
        const int cc = tid >> 3, r8 = (tid & 7) * 8;
        float f[8];
#pragma unroll
        for (int q = 0; q < 8; ++q) f[q] = tile[cc * 65 + r8 + q];
        u32x4 w; w.x = cvt_pk_bf16(f[0], f[1]); w.y = cvt_pk_bf16(f[2], f[3]); w.z = cvt_pk_bf16(f[4], f[5]); w.w = cvt_pk_bf16(f[6], f[7]);
        bf16_t* rowp = j.mode == 1 ? win_dstrow(c0 + cc, j.dst, j.dst2) : j.dst + (size_t)(c0 + cc) * j.Kdim;
        *(u32x4*)(rowp + k0 + r8) = w;
    }
}

DI void prologue(LAS unsigned char* lds, const Params& P, int G) {
    unsigned char* misc = P.ws + 7 * SLOT;
    const int tid = opaque_tid(), lane = tid & 63, wid = tid >> 6;
    {
        int t = blockIdx.x; int par = 0;
        TJob cur = tjob(P, misc, t); f32x4 v[2]; tconv_load(cur, tid, v);
        while (t < 4928) {
            const int tn_ = t + G; const bool hn = tn_ < 4928;
            TJob nx = cur; f32x4 vn[2] = {v[0], v[1]};
            if (hn) { nx = tjob(P, misc, tn_); tconv_load(nx, tid, vn); }
            tconv_finish((LAS float*)(lds + par * 16640), cur, tid, v);
            cur = nx; v[0] = vn[0]; v[1] = vn[1]; t = tn_; par ^= 1;
        }
        __syncthreads();
    }
    const size_t gtid = (size_t)blockIdx.x * 512 + tid, gthreads = (size_t)G * 512;
    {
        float* rope = (float*)(misc + OFF_ROPE);
        for (size_t i = gtid; i < (size_t)SEQ * 32; i += gthreads) {
            const int pos = (int)(i >> 5), f = (int)(i & 31);
            const float inv = 1.0f / powf(10000.0f, (float)(2 * f) / 64.0f);
            const float ang = (float)pos * inv;
            const double a = (double)ang; const double kq = __builtin_rint(a * 0.15915494309189535); const float rr = (float)(a - kq * 6.283185307179586);
            rope[2 * i] = cosf(rr); rope[2 * i + 1] = sinf(rr);
        }
    }
    { float* ss = (float*)(misc + OFF_SS); for (size_t i = gtid; i < (size_t)3 * MT; i += gthreads) ss[i] = 0.f; }
    {
        bf16_t* wsb = (bf16_t*)(misc + OFF_WS); const float* w = P.in[6];
        for (size_t i = gtid; i < (size_t)8 * 128 * 128; i += gthreads) {
            const int s = (int)(i & 127), t = (int)((i >> 7) & 127);
            const float v = ((s >> 6) <= (t >> 6)) ? w[i] : 0.f;
            wsb[i] = (bf16_t)(cvt_pk_bf16(v, 0.f) & 0xffffu);
        }
    }
    {
        const f32x4* p4 = (const f32x4*)P.in[1]; u32x2* pb = (u32x2*)(misc + OFF_PB);
        for (size_t i = gtid; i < (size_t)MT * PLED / 4; i += gthreads) { const f32x4 v = p4[i]; u32x2 w; w.x = cvt_pk_bf16(v[0], v[1]); w.y = cvt_pk_bf16(v[2], v[3]); pb[i] = w; }
    }
    {
        const float* x = P.in[0]; const float* g = P.in[2]; bf16_t* xn = (bf16_t*)(P.ws);
        f32x4 gv[4];
#pragma unroll
        for (int i = 0; i < 4; ++i) gv[i] = *(const f32x4*)(g + 256 * i + lane * 4);
        for (int row = blockIdx.x * 8 + wid; row < MT; row += G * 8) {
            f32x4 v[4]; float s = 0.f;
#pragma unroll
            for (int i = 0; i < 4; ++i) { v[i] = *(const f32x4*)(x + (size_t)row * DM + 256 * i + lane * 4); s += (v[i][0] * v[i][0] + v[i][1] * v[i][1]) + (v[i][2] * v[i][2] + v[i][3] * v[i][3]); }
            s = wave_sum(s);
            const float rs = rsqrtf(s * (1.0f / DM) + EPSV);
#pragma unroll
            for (int i = 0; i < 4; ++i) { u32x2 w; w.x = cvt_pk_bf16(v[i][0] * rs * gv[i][0], v[i][1] * rs * gv[i][1]); w.y = cvt_pk_bf16(v[i][2] * rs * gv[i][2], v[i][3] * rs * gv[i][3]);
                *(u32x2*)(xn + (size_t)row * DM + 256 * i + lane * 4) = w; }
        }
    }
}

DI void elementwise_phase(const Params& P, int which, int G) {
    unsigned char* misc = P.ws + 7 * SLOT;
    const int tid = opaque_tid(), lane = tid & 63, wid = tid >> 6;
    const float* ssb = (const float*)(misc + OFF_SS) + (size_t)which * MT;
    bf16_t* H = (bf16_t*)P.ws;
    const bf16_t* raw = which == 0 ? (const bf16_t*)(P.ws + 2 * SLOT) : which == 1 ? (const bf16_t*)P.out : (const bf16_t*)(P.ws + 4 * SLOT);
    const float* g1 = which == 0 ? P.in[16] : which == 1 ? P.in[20] : P.in[24];
    bf16_t* dstb = which == 0 ? (bf16_t*)P.out : (bf16_t*)(P.ws + 2 * SLOT);
    f32x4 gv[4], g2[4];
#pragma unroll
    for (int i = 0; i < 4; ++i) { const int col = 512 * (i >> 1) + lane * 8 + 4 * (i & 1); gv[i] = *(const f32x4*)(g1 + col); g2[i] = which == 0 ? *(const f32x4*)(P.in[17] + col) : (f32x4){1.f, 1.f, 1.f, 1.f}; }
    for (int row = blockIdx.x * 8 + wid; row < MT; row += G * 8) {
        const float rs = rsqrtf(ssb[row] * (1.0f / DM) + EPSV);
        f32x4 h[4]; float s = 0.f;
#pragma unroll
        for (int c = 0; c < 2; ++c) {
            const size_t o = (size_t)row * DM + 512 * c + lane * 8;
            f32x4 b0, b1;
            if (which == 0) { b0 = *(const f32x4*)(P.in[0] + o); b1 = *(const f32x4*)(P.in[0] + o + 4); }
            else { const u32x4 hw = *(const u32x4*)(H + o); b0 = (f32x4){bf_lo(hw.x), bf_hi(hw.x), bf_lo(hw.y), bf_hi(hw.y)}; b1 = (f32x4){bf_lo(hw.z), bf_hi(hw.z), bf_lo(hw.w), bf_hi(hw.w)}; }
            const u32x4 rw = *(const u32x4*)(raw + o);
            const f32x4 r0 = {bf_lo(rw.x), bf_hi(rw.x), bf_lo(rw.y), bf_hi(rw.y)}, r1 = {bf_lo(rw.z), bf_hi(rw.z), bf_lo(rw.w), bf_hi(rw.w)};
            h[2 * c] = b0 + r0 * rs * gv[2 * c]; h[2 * c + 1] = b1 + r1 * rs * gv[2 * c + 1];
        }
#pragma unroll
        for (int i = 0; i < 4; ++i) s += (h[i][0] * h[i][0] + h[i][1] * h[i][1]) + (h[i][2] * h[i][2] + h[i][3] * h[i][3]);
        float rs2 = 1.0f;
        if (which == 0) { s = wave_sum(s); rs2 = rsqrtf(s * (1.0f / DM) + EPSV); }
#pragma unroll
        for (int c = 0; c < 2; ++c) {
            const size_t o = (size_t)row * DM + 512 * c + lane * 8;
            const f32x4 h0 = h[2 * c], h1 = h[2 * c + 1];
            if (which == 2) { *(f32x4*)(P.out + o) = h0; *(f32x4*)(P.out + o + 4) = h1; }
            else {
                u32x4 hw; hw.x = cvt_pk_bf16(h0[0], h0[1]); hw.y = cvt_pk_bf16(h0[2], h0[3]); hw.z = cvt_pk_bf16(h1[0], h1[1]); hw.w = cvt_pk_bf16(h1[2], h1[3]);
                *(u32x4*)(H + o) = hw;
                if (which == 0) { const f32x4 a0 = h0 * rs2 * g2[2 * c], a1 = h1 * rs2 * g2[2 * c + 1];
                    u32x4 w; w.x = cvt_pk_bf16(a0[0], a0[1]); w.y = cvt_pk_bf16(a0[2], a0[3]); w.z = cvt_pk_bf16(a1[0], a1[1]); w.w = cvt_pk_bf16(a1[2], a1[3]); *(u32x4*)(dstb + o) = w; }
                else *(u32x4*)(dstb + o) = hw;
            }
        }
    }
}

typedef short s16x4 __attribute__((ext_vector_type(4)));
DI void gmlp_phase(LAS unsigned char* lds, const Params& P, int G) {
    unsigned char* misc = P.ws + 7 * SLOT;
    const int tid = opaque_tid(), lane = tid & 63, wid = tid >> 6, fr = lane & 15, fq = lane >> 4;
    bf16_t* U = (bf16_t*)(P.ws + 1 * SLOT); const bf16_t* V = (const bf16_t*)(P.ws + 2 * SLOT);
    const bf16_t* WS = (const bf16_t*)(misc + OFF_WS);
    const float* lng = P.in[4]; const float* lnb = P.in[5]; const float* bs = P.in[7];
    LAS float* st = (LAS float*)lds;
    LAS unsigned char* vs = lds + 1024;
    constexpr int PV = 272;
    const int trq = fr >> 2, trp = fr & 3;
    for (int blk = blockIdx.x; blk < MT / 128; blk += G) {
        const size_t tok0 = (size_t)blk * 128;
        for (int r4 = 0; r4 < 4; ++r4) {
            float sm[4], sq[4];
#pragma unroll
            for (int e = 0; e < 4; ++e) {
                const bf16_t* vp = V + (tok0 + wid * 16 + r4 * 4 + e) * DM;
                const u32x4 a = *(const u32x4*)(vp + lane * 8), b2 = *(const u32x4*)(vp + 512 + lane * 8);
                float s0 = 0.f, q0 = 0.f;
#pragma unroll
                for (int j = 0; j < 4; ++j) { const float x0 = bf_lo(a[j]), x1 = bf_hi(a[j]), y0 = bf_lo(b2[j]), y1 = bf_hi(b2[j]); s0 += (x0 + x1) + (y0 + y1); q0 += (x0 * x0 + x1 * x1) + (y0 * y0 + y1 * y1); }
                sm[e] = s0; sq[e] = q0;
            }
#pragma unroll
            for (int o = 32; o >= 1; o >>= 1) {
#pragma unroll
                for (int e = 0; e < 4; ++e) { sm[e] += __shfl_xor(sm[e], o); sq[e] += __shfl_xor(sq[e], o); }
            }
            if (lane < 4) {
                const float s0 = lane == 0 ? sm[0] : lane == 1 ? sm[1] : lane == 2 ? sm[2] : sm[3];
                const float q0 = lane == 0 ? sq[0] : lane == 1 ? sq[1] : lane == 2 ? sq[2] : sq[3];
                const float mu = s0 * (1.0f / DM); const float var = fmaxf(q0 * (1.0f / DM) - mu * mu, 0.f);
                const int row = wid * 16 + r4 * 4 + lane; st[row * 2] = mu; st[row * 2 + 1] = rsqrtf(var + EPSV);
            }
        }
        u32x4 vreg[4];
#pragma unroll
        for (int i = 0; i < 4; ++i) { const int id = tid + 512 * i; vreg[i] = *(const u32x4*)(V + (tok0 + (id >> 4)) * DM + (id & 15) * 8); }
        u32x4 unext[4];
#pragma unroll
        for (int np = 0; np < 4; ++np) unext[np] = *(const u32x4*)(U + (tok0 + 16 * wid + fr) * DM + 32 * np + 8 * fq);
        __syncthreads();
        for (int g = 0; g < 8; ++g) {
#pragma unroll
            for (int i = 0; i < 4; ++i) {
                const int id = tid + 512 * i, sr = id >> 4, cc = (id & 15) * 8;
                const u32x4 v = vreg[i];
                const float mu = st[2 * sr], rs = st[2 * sr + 1];
                const f32x4 ga = *(const f32x4*)(lng + g * 128 + cc), gb = *(const f32x4*)(lng + g * 128 + cc + 4);
                const f32x4 ba = *(const f32x4*)(lnb + g * 128 + cc), bb = *(const f32x4*)(lnb + g * 128 + cc + 4);
                u32x4 w;
                w.x = cvt_pk_bf16((bf_lo(v.x) - mu) * rs * ga[0] + ba[0], (bf_hi(v.x) - mu) * rs * ga[1] + ba[1]);
                w.y = cvt_pk_bf16((bf_lo(v.y) - mu) * rs * ga[2] + ba[2], (bf_hi(v.y) - mu) * rs * ga[3] + ba[3]);
                w.z = cvt_pk_bf16((bf_lo(v.z) - mu) * rs * gb[0] + bb[0], (bf_hi(v.z) - mu) * rs * gb[1] + bb[1]);
                w.w = cvt_pk_bf16((bf_lo(v.w) - mu) * rs * gb[2] + bb[2], (bf_hi(v.w) - mu) * rs * gb[3] + bb[3]);
                *(LAS u32x4*)(vs + sr * PV + cc * 2) = w;
            }
            const int t = 16 * wid + fr;
            bf16x8 wa[4];
#pragma unroll
            for (int kk = 0; kk < 4; ++kk) wa[kk] = *(const bf16x8*)(WS + (size_t)(g * 128 + t) * 128 + 32 * kk + 8 * fq);
            u32x4 uu[4];
#pragma unroll
            for (int np = 0; np < 4; ++np) uu[np] = unext[np];
            if (g < 7) {
#pragma unroll
                for (int np = 0; np < 4; ++np) unext[np] = *(const u32x4*)(U + (tok0 + t) * DM + (g + 1) * 128 + 32 * np + 8 * fq);
            }
            if (g < 7) {
#pragma unroll
                for (int i = 0; i < 4; ++i) { const int id = tid + 512 * i; vreg[i] = *(const u32x4*)(V + (tok0 + (id >> 4)) * DM + (g + 1) * 128 + (id & 15) * 8); }
            }
            const float bsv = bs[g * 128 + t];
            asm volatile("s_waitcnt lgkmcnt(0)" ::: "memory"); __builtin_amdgcn_s_barrier(); asm volatile("" ::: "memory");
            f32x4 acc[8];
#pragma unroll
            for (int n = 0; n < 8; ++n) acc[n] = (f32x4){0.f, 0.f, 0.f, 0.f};
#pragma unroll
            for (int kk = 0; kk < 4; ++kk) {
#pragma unroll
                for (int n = 0; n < 8; ++n) {
                    LAS unsigned char* ap = vs + (32 * kk + 8 * fq + trq) * PV + 64 * (n >> 1) + 16 * trp + 8 * (n & 1);
                    const s16x4 lo = __builtin_amdgcn_ds_read_tr16_b64_v4i16((LAS s16x4*)ap);
                    const s16x4 hi = __builtin_amdgcn_ds_read_tr16_b64_v4i16((LAS s16x4*)(ap + 4 * PV));
                    const bf16x8 bfr = __builtin_shufflevector(lo, hi, 0, 1, 2, 3, 4, 5, 6, 7);
                    acc[n] = __builtin_amdgcn_mfma_f32_16x16x32_bf16(bfr, wa[kk], acc[n], 0, 0, 0);
                }
            }
#pragma unroll
            for (int np = 0; np < 4; ++np) {
                bf16_t* up = U + (tok0 + t) * DM + g * 128 + 32 * np + 8 * fq;
                const f32x4 a0 = acc[2 * np], a1 = acc[2 * np + 1]; const u32x4 u4 = uu[np];
                u32x4 w;
                w.x = cvt_pk_bf16(bf_lo(u4.x) * (a0[0] + bsv), bf_hi(u4.x) * (a0[1] + bsv)); w.y = cvt_pk_bf16(bf_lo(u4.y) * (a0[2] + bsv), bf_hi(u4.y) * (a0[3] + bsv));
                w.z = cvt_pk_bf16(bf_lo(u4.z) * (a1[0] + bsv), bf_hi(u4.z) * (a1[1] + bsv)); w.w = cvt_pk_bf16(bf_lo(u4.w) * (a1[2] + bsv), bf_hi(u4.w) * (a1[3] + bsv));
                *(u32x4*)up = w;
            }
            asm volatile("s_waitcnt lgkmcnt(0)" ::: "memory"); __builtin_amdgcn_s_barrier(); asm volatile("" ::: "memory");
        }
    }
}

constexpr int ATT_KBUF = 16384, ATT_KCOMP = 8192, ATT_VBASE = 4 * ATT_KBUF, ATT_VBUF = 16384, ATT_XOFF = 0;
DI bf16x8 pack8(const f32x16& s, int b) {
    u32x4 p; p.x = cvt_pk_bf16(s[b + 0], s[b + 1]); p.y = cvt_pk_bf16(s[b + 2], s[b + 3]); p.z = cvt_pk_bf16(s[b + 4], s[b + 5]); p.w = cvt_pk_bf16(s[b + 6], s[b + 7]);
    return __builtin_bit_cast(bf16x8, p);
}
DI bf16x8 att_kfrag(LAS const unsigned char* Kb, int rowoff, int kk, int yb) { return *(LAS const bf16x8*)(Kb + rowoff + ((32 * kk) ^ yb)); }
DI bf16x8 att_vfrag(LAS const unsigned char* Vb, int d, int rowoff, int ks, int yb) { return *(LAS const bf16x8*)(Vb + d * 4096 + rowoff + ((32 * ks) ^ yb)); }
DI float att_rowmax1(const f32x16& S) {
    float mx = fmaxf(S[0], S[1]);
#pragma unroll
    for (int i = 2; i < 16; i += 2) mx = fmaxf(fmaxf(mx, S[i]), S[i + 1]);
    return xhalf_max(mx);
}
template <bool HAS_NEXT>
DI void att_half(f32x16& C, f32x16& N, f32x16 (&o)[4], const bf16x8 (&qf)[4], f32x16& negm, float& lrun, float& cmx,
                 LAS const unsigned char* Kn, LAS const unsigned char* Vb, int ks0, int kro, int kyb, int vro, int vyb) {
    if (__builtin_amdgcn_ballot_w64(cmx > 6.0f) != 0ull) {
        const float dlt = fmaxf(cmx, 0.f); const float sc = fast_exp2(-dlt); lrun *= sc;
#pragma unroll
        for (int i = 0; i < 16; ++i) { C[i] -= dlt; negm[i] -= dlt; }
#pragma unroll
        for (int d = 0; d < 4; ++d)
#pragma unroll
            for (int i = 0; i < 16; ++i) o[d][i] *= sc;
    }
    float ps = 0.f;
    bf16x8 vf[4];
    if (HAS_NEXT) {
        bf16x8 kf[2];
        kf[0] = att_kfrag(Kn, kro, 0, kyb);
#pragma unroll
        for (int kk = 0; kk < 4; ++kk) {
            if (kk < 3) kf[(kk + 1) & 1] = att_kfrag(Kn, kro, kk + 1, kyb);
            if (kk == 3) {
#pragma unroll
                for (int d = 0; d < 4; ++d) vf[d] = att_vfrag(Vb, d, vro, ks0, vyb);
            }
            N = __builtin_amdgcn_mfma_f32_32x32x16_bf16(kf[kk & 1], qf[kk], kk == 0 ? negm : N, 0, 0, 0);
#pragma unroll
            for (int i = 4 * kk; i < 4 * kk + 4; ++i) { C[i] = fast_exp2(C[i]); ps += C[i]; }
            __builtin_amdgcn_sched_barrier(0);
        }
    } else {
#pragma unroll
        for (int d = 0; d < 4; ++d) vf[d] = att_vfrag(Vb, d, vro, ks0, vyb);
#pragma unroll
        for (int i = 0; i < 16; ++i) { C[i] = fast_exp2(C[i]); ps += C[i]; }
    }
    lrun += ps;
    bf16x8 pf[2]; pf[0] = pack8(C, 0); pf[1] = pack8(C, 8);
#pragma unroll
    for (int d = 0; d < 4; ++d) o[d] = __builtin_amdgcn_mfma_f32_32x32x16_bf16(vf[d], pf[0], o[d], 0, 0, 0);
    __builtin_amdgcn_sched_barrier(0);
    bf16x8 vg[4];
#pragma unroll
    for (int d = 0; d < 4; ++d) vg[d] = att_vfrag(Vb, d, vro, ks0 + 1, vyb);
    if (HAS_NEXT) {
        float pm = fmaxf(N[0], N[1]);
#pragma unroll
        for (int i = 2; i < 16; i += 2) pm = fmaxf(fmaxf(pm, N[i]), N[i + 1]);
        cmx = xhalf_max(pm);
    }
#pragma unroll
    for (int d = 0; d < 4; ++d) o[d] = __builtin_amdgcn_mfma_f32_32x32x16_bf16(vg[d], pf[1], o[d], 0, 0, 0);
    __builtin_amdgcn_sched_barrier(0);
}
#define ATT_DMA_K(KT, BUF) do { _Pragma("unroll") for (int i = 0; i < 2; ++i) \
    __builtin_amdgcn_global_load_lds((const unsigned*)(kgp[i] + (size_t)(KT) * 64 * 128), (LAS unsigned*)(lds + (BUF) * ATT_KBUF + (wid * 2 + i) * 1024), 16, 0, 0); } while (0)
#define ATT_DMA_V(KT, BUF) do { _Pragma("unroll") for (int i = 0; i < 2; ++i) \
    __builtin_amdgcn_global_load_lds((const unsigned*)(vgp[i] + (size_t)(KT) * 8192), (LAS unsigned*)(lds + ATT_VBASE + (BUF) * ATT_VBUF + (wid * 2 + i) * 1024), 16, 0, 0); } while (0)

DI void att_tile_id(int idx, int G, int& b, int& h, int& qt) {
    const int u = blockIdx.x + (idx >> 1) * G;
    const int k = u / 256, w = u % 256, bh = k * 8 + (w & 7), j = w >> 3;
    b = bh >> 3; h = bh & 7; qt = (idx & 1) ? j : 63 - j;
}
DI void attn_phase(LAS unsigned char* lds, const Params& P, int G) {
    const bf16_t* Qg = (const bf16_t*)(P.ws + 3 * SLOT); const bf16_t* Kg = (const bf16_t*)(P.ws + 4 * SLOT); const bf16_t* Vtg = (const bf16_t*)(P.ws + 5 * SLOT);
    bf16_t* Og = (bf16_t*)(P.ws + 3 * SLOT);
    const float* subg = P.in[12];
    float d1 = 0.f, d2 = 0.f;
    for (int i = 0; i < 64; ++i) { d1 += P.in[8][i] * P.in[9][i]; d2 += P.in[10][i] * P.in[11][i]; }
    const float lam = expf(d1) - expf(d2) + 0.2f;
    const int tid = opaque_tid(), lane = tid & 63, wid = __builtin_amdgcn_readfirstlane(tid >> 6);
    const int comp = wid & 1, rg = wid >> 1, r = lane & 31, h2 = lane >> 5;
    const int pr = (r & 19) | ((r & 4) << 1) | ((r & 8) >> 1);
    const int kro = pr * 128, kyb = 16 * (h2 ^ ((pr >> 1) & 7)), vro = r * 128, vyb = 16 * (h2 ^ ((r >> 1) & 7));
    int ntiles = 0; for (int u = blockIdx.x; u < 2048; u += G) ntiles += 2;
#define ATT_BARV(N) do { asm volatile("s_waitcnt vmcnt(" #N ") lgkmcnt(0)" ::: "memory"); __builtin_amdgcn_s_barrier(); asm volatile("" ::: "memory"); } while (0)
#define ATT_BARL() do { asm volatile("s_waitcnt lgkmcnt(0)" ::: "memory"); __builtin_amdgcn_s_barrier(); asm volatile("" ::: "memory"); } while (0)
#define ATT_SETUP(B_, H_, QT_, KGP, VGP, QF) do { \
    _Pragma("unroll") for (int i = 0; i < 2; ++i) { \
        const int j = wid * 2 + i; \
        const int krow = (j & 7) * 8 + (lane >> 3), kc = (lane & 7) ^ ((krow >> 1) & 7); \
        KGP[i] = Kg + ((size_t)((B_) * 8 + (H_)) * SEQ + krow) * 128 + (j >> 3) * 64 + kc * 8; \
        const int d = j * 8 + (lane >> 3), vc = (lane & 7) ^ ((d >> 1) & 7); \
        VGP[i] = Vtg + (size_t)((B_) * 8 + (H_)) * 128 * 8192 + d * 64 + vc * 8; } \
    const bf16_t* qp = Qg + ((size_t)(B_) * SEQ + (QT_) * 128 + rg * 32 + r) * DM + (H_) * 128 + comp * 64 + 8 * h2; \
    _Pragma("unroll") for (int kk = 0; kk < 4; ++kk) QF[kk] = *(const bf16x8*)(qp + 16 * kk); } while (0)
    if (ntiles == 0) return;
    int b, h, qt; att_tile_id(0, G, b, h, qt);
    const bf16_t* kgp[2]; const bf16_t* vgp[2]; bf16x8 qf[4];
    ATT_SETUP(b, h, qt, kgp, vgp, qf);
    ATT_DMA_K(0, 0); ATT_DMA_K(1, 1); if (qt > 0) ATT_DMA_K(2, 2);
    for (int idx = 0; idx < ntiles; ++idx) {
        const int q0 = qt * 128 + rg * 32;
        const int nkt = 2 * qt + 2, nkt_w = 2 * qt + (rg >> 1) + 1;
        const size_t tokbase = (size_t)b * SEQ;
        ATT_DMA_V(0, 0); ATT_DMA_V(1, 1);
        ATT_BARV(2);
        f32x16 o[4];
#pragma unroll
        for (int d = 0; d < 4; ++d)
#pragma unroll
            for (int i = 0; i < 16; ++i) o[d][i] = 0.f;
        float lrun = 0.f;
        f32x16 sA, sB, negm; float cmx;
        {
            LAS const unsigned char* Kb0 = lds + comp * ATT_KCOMP;
            f32x16 z;
#pragma unroll
            for (int i = 0; i < 16; ++i) z[i] = 0.f;
            sA = z;
#pragma unroll
            for (int kk = 0; kk < 4; ++kk) sA = __builtin_amdgcn_mfma_f32_32x32x16_bf16(att_kfrag(Kb0, kro, kk, kyb), qf[kk], sA, 0, 0, 0);
            const float m0 = att_rowmax1(sA);
#pragma unroll
            for (int i = 0; i < 16; ++i) { sA[i] -= m0; negm[i] = -m0; }
            cmx = 0.f;
            sB = z;
        }
        int vb_cur = 0, vb_fill = 2;
        for (int kt = 0; kt < nkt - 1; ++kt) {
            const bool dk = (kt + 3 < nkt), dv = (kt + 2 < nkt);
            if (dk) ATT_DMA_K(kt + 3, (kt + 3) & 3);
            LAS const unsigned char* Vb = lds + ATT_VBASE + vb_cur * ATT_VBUF;
            att_half<true>(sA, sB, o, qf, negm, lrun, cmx, lds + (kt & 3) * ATT_KBUF + comp * ATT_KCOMP + 4096, Vb, 0, kro, kyb, vro, vyb);
            if (dv) ATT_DMA_V(kt + 2, vb_fill);
            att_half<true>(sB, sA, o, qf, negm, lrun, cmx, lds + ((kt + 1) & 3) * ATT_KBUF + comp * ATT_KCOMP, Vb, 2, kro, kyb, vro, vyb);
            vb_cur = (vb_cur == 2) ? 0 : vb_cur + 1; vb_fill = (vb_fill == 2) ? 0 : vb_fill + 1;
            if (dk) ATT_BARV(4); else if (dv) ATT_BARV(2); else ATT_BARV(0);
        }
        if (nkt_w == nkt) {
            LAS const unsigned char* Vb = lds + ATT_VBASE + vb_cur * ATT_VBUF;
            att_half<true>(sA, sB, o, qf, negm, lrun, cmx, lds + ((nkt - 1) & 3) * ATT_KBUF + comp * ATT_KCOMP + 4096, Vb, 0, kro, kyb, vro, vyb);
            att_half<false>(sB, sA, o, qf, negm, lrun, cmx, lds + (nkt & 3) * ATT_KBUF + comp * ATT_KCOMP, Vb, 2, kro, kyb, vro, vyb);
        }
        ATT_BARV(0);
        int nb = b, nh = h, nqt = qt; const bool has_next = idx + 1 < ntiles;
        const bf16_t* kgn[2] = {kgp[0], kgp[1]}; const bf16_t* vgn[2] = {vgp[0], vgp[1]}; bf16x8 qn[4] = {qf[0], qf[1], qf[2], qf[3]};
        if (has_next) {
            att_tile_id(idx + 1, G, nb, nh, nqt);
            ATT_SETUP(nb, nh, nqt, kgn, vgn, qn);
            { const bf16_t* const* kgp_s = kgn; (void)kgp_s; }
#define kgp kgn
            ATT_DMA_K(0, 0); ATT_DMA_K(1, 1); if (nqt > 0) ATT_DMA_K(2, 2);
#undef kgp
        }
        const float ltot = lrun + __shfl_xor(lrun, 32);
        const float inv = 1.0f / ltot;
        LAS float* xs = (LAS float*)(lds + 65536) + rg * 4096;
        if (comp == 1) {
#pragma unroll
            for (int d = 0; d < 4; ++d)
#pragma unroll
                for (int i = 0; i < 16; ++i) xs[(d * 16 + i) * 64 + lane] = o[d][i] * inv;
        }
        ATT_BARL();
        if (comp == 0) {
            float ssq = 0.f;
#pragma unroll
            for (int d = 0; d < 4; ++d)
#pragma unroll
                for (int i = 0; i < 16; ++i) { const float v = o[d][i] * inv - lam * xs[(d * 16 + i) * 64 + lane]; o[d][i] = v; ssq += v * v; }
            ssq += __shfl_xor(ssq, 32);
            const float rs = rsqrtf(ssq * (1.0f / 128.0f) + EPSV) * 0.8f;
            bf16_t* op = Og + (tokbase + q0 + r) * DM + h * 128;
#pragma unroll
            for (int d = 0; d < 4; ++d)
#pragma unroll
                for (int k2 = 0; k2 < 2; ++k2) {
                    u32x2 wa, wb;
                    { const int g4 = 2 * k2, dd = 32 * d + 8 * g4 + 4 * h2; const f32x4 gg = *(const f32x4*)(subg + dd);
                      wa.x = cvt_pk_bf16(o[d][4 * g4 + 0] * rs * gg[0], o[d][4 * g4 + 1] * rs * gg[1]); wa.y = cvt_pk_bf16(o[d][4 * g4 + 2] * rs * gg[2], o[d][4 * g4 + 3] * rs * gg[3]); }
                    { const int g4 = 2 * k2 + 1, dd = 32 * d + 8 * g4 + 4 * h2; const f32x4 gg = *(const f32x4*)(subg + dd);
                      wb.x = cvt_pk_bf16(o[d][4 * g4 + 0] * rs * gg[0], o[d][4 * g4 + 1] * rs * gg[1]); wb.y = cvt_pk_bf16(o[d][4 * g4 + 2] * rs * gg[2], o[d][4 * g4 + 3] * rs * gg[3]); }
                    const auto sx = __builtin_amdgcn_permlane32_swap(wa.x, wb.x, false, false);
                    const auto sy = __builtin_amdgcn_permlane32_swap(wa.y, wb.y, false, false);
                    u32x4 w; w.x = sx[0]; w.y = sy[0]; w.z = sx[1]; w.w = sy[1];
                    *(u32x4*)(op + 32 * d + 16 * k2 + 8 * h2) = w;
                }
        }
        ATT_BARL();
        b = nb; h = nh; qt = nqt;
#pragma unroll
        for (int i = 0; i < 2; ++i) { kgp[i] = kgn[i]; vgp[i] = vgn[i]; }
#pragma unroll
        for (int kk = 0; kk < 4; ++kk) qf[kk] = qn[kk];
    }
    asm volatile("s_waitcnt vmcnt(0)" ::: "memory");
#undef ATT_BARV
#undef ATT_BARL
#undef ATT_SETUP
}

#define XB_TMO      128
#define XB_XCNT(j)  (256  + 64 * (j))
#define XB_XSUB(j)  (1280 + 64 * (j))
#define XB_XGEN(j)  (2304 + 64 * (j))
#define XB_TOP      3328
#define XB_TOPGEN   3392
#define XCD_BAR_WORDS 3456
#define XB_SPIN_CAP (1u << 22)
DI unsigned xb_ld(unsigned* p)              { return __hip_atomic_load(p, __ATOMIC_RELAXED, __HIP_MEMORY_SCOPE_AGENT); }
DI unsigned xb_add(unsigned* p, unsigned v) { return __hip_atomic_fetch_add(p, v, __ATOMIC_RELAXED, __HIP_MEMORY_SCOPE_AGENT); }
DI unsigned xb_xcc_id() { return (unsigned)__builtin_amdgcn_s_getreg((3 << 11) | 20) & 0xFu; }
#define XB_SPIN(cond, bar) do { unsigned _sp = 0; while (cond) { __builtin_amdgcn_s_sleep(1); \
    if ((++_sp & 255u) == 0u) { if (xb_ld(&(bar)[XB_TMO])) break; if (_sp > XB_SPIN_CAP) { atomicAdd(&(bar)[XB_TMO], 1u); break; } } } } while (0)
struct XcdBarrier { unsigned* bar; unsigned x; volatile LAS unsigned* st; };
DI XcdBarrier xcd_barrier_post(unsigned* bar, volatile LAS unsigned* st) {
    XcdBarrier b; b.bar = bar; b.x = xb_xcc_id(); b.st = st;
    if (threadIdx.x == 0) (void)xb_add(&bar[XB_XCNT(b.x)], 1u);
    return b;
}
DI void xcd_barrier_complete(unsigned* bar, unsigned x, unsigned& nloc, unsigned& nx) {
    const unsigned G = gridDim.x * gridDim.y * gridDim.z;
    unsigned sum, cnt, mine, sp = 0u;
    for (;;) {
        sum = 0u; cnt = 0u; mine = 0u;
#pragma unroll
        for (unsigned j = 0; j < 16; ++j) { const unsigned c = xb_ld(&bar[XB_XCNT(j)]); sum += c; cnt += (c > 0u) ? 1u : 0u; mine = (j == x) ? c : mine; }
        if (sum == G) break;
        __builtin_amdgcn_s_sleep(1);
        if ((++sp & 255u) == 0u) { if (xb_ld(&bar[XB_TMO])) break; if (sp > XB_SPIN_CAP) { atomicAdd(&bar[XB_TMO], 1u); break; } }
    }
    nloc = mine > 0u ? mine : 1u; nx = cnt > 0u ? cnt : 1u;
}
DI void xcd_barrier(const XcdBarrier& b) {
    asm volatile("s_waitcnt vmcnt(0)" ::: "memory");
    __syncthreads();
    if (threadIdx.x == 0) {
        unsigned* bar = b.bar;
        __builtin_amdgcn_s_waitcnt(0);
        unsigned nloc = b.st[0], nx = b.st[1];
        if (nloc == 0u) { xcd_barrier_complete(bar, b.x, nloc, nx); b.st[0] = nloc; b.st[1] = nx; }
        const unsigned old = xb_add(&bar[XB_XSUB(b.x)], 1u);
        const unsigned gen = old / nloc;
        if (old + 1u == (gen + 1u) * nloc) {
            __builtin_amdgcn_fence(__ATOMIC_RELEASE, "agent");
            asm volatile("s_waitcnt vmcnt(0)" ::: "memory");
            const unsigned og = xb_add(&bar[XB_TOP], 1u);
            const unsigned tg = og / nx;
            if (og + 1u == (tg + 1u) * nx) xb_add(&bar[XB_TOPGEN], 1u);
            else XB_SPIN(xb_ld(&bar[XB_TOPGEN]) == tg, bar);
            __builtin_amdgcn_fence(__ATOMIC_ACQUIRE, "agent");
            xb_add(&bar[XB_XGEN(b.x)], 1u);
            asm volatile("s_waitcnt vmcnt(0)" ::: "memory");
        } else {
            XB_SPIN(xb_ld(&bar[XB_XGEN(b.x)]) == gen, bar);
            __builtin_amdgcn_fence(__ATOMIC_ACQUIRE, "agent");
            asm volatile("s_waitcnt vmcnt(0)" ::: "memory");
        }
    }
    __syncthreads();
}

DI GemmJob make_job(const Params& P, int ph, int g) {
    unsigned char* ws = P.ws; unsigned char* misc = ws + 7 * SLOT;
    GemmJob J{};
    J.ldc = DM; J.rope = (const float*)(misc + OFF_ROPE);
    if (ph == 1 && g == 0) { J.A = (const bf16_t*)ws; J.Bt = (const bf16_t*)(misc + OFF_WIN); J.M = MT; J.N = 6144; J.K = DM; J.mode = EPI_IN; J.in_base = (bf16_t*)(ws + SLOT); J.gb_base = (bf16_t*)P.out; }
    else if (ph == 1) { J.A = (const bf16_t*)(misc + OFF_WVA); J.Bt = (const bf16_t*)ws; J.M = 1024; J.N = MT; J.K = DM; J.mode = EPI_VT; J.o0 = (bf16_t*)(ws + 5 * SLOT); J.ldc = MT; }
    else if (ph == 3 && g == 0) { J.A = (const bf16_t*)(ws + SLOT); J.Bt = (const bf16_t*)(misc + OFF_WA); J.M = MT; J.N = DM; J.K = DM; J.mode = EPI_BRA; J.o0 = (bf16_t*)(ws + 6 * SLOT); }
    else if (ph == 3) { J.A = (const bf16_t*)(ws + 3 * SLOT); J.Bt = (const bf16_t*)(misc + OFF_WB); J.M = MT; J.N = DM; J.K = DM; J.mode = EPI_BRB; J.o0 = (bf16_t*)P.out; J.i0 = (const bf16_t*)(ws + 6 * SLOT); }
    else if (ph == 4) { J.A = (const bf16_t*)P.out; J.Bt = (const bf16_t*)(misc + OFF_WO); J.M = MT; J.N = DM; J.K = DM; J.mode = EPI_RAW; J.fo = (float*)(ws + 2 * SLOT); J.ss = (float*)(misc + OFF_SS); }
    else if (ph == 6) { J.A = (const bf16_t*)P.out; J.Bt = (const bf16_t*)(misc + OFF_WF1); J.M = MT; J.N = FFW; J.K = DM; J.mode = EPI_RELU2; J.o0 = (bf16_t*)(ws + 3 * SLOT); J.ldc = FFW; }
    else if (ph == 7) { J.A = (const bf16_t*)(ws + 3 * SLOT); J.Bt = (const bf16_t*)(misc + OFF_WF2); J.M = MT; J.N = DM; J.K = FFW; J.mode = EPI_RAW; J.fo = P.out; J.ss = (float*)(misc + OFF_SS) + MT; }
    else if (ph == 9 && g == 0) { J.A = (const bf16_t*)(misc + OFF_PB); J.Bt = (const bf16_t*)(misc + OFF_WP); J.M = MT; J.N = DM; J.K = PLED; J.mode = EPI_BF16; J.o0 = (bf16_t*)(ws + 3 * SLOT); }
    else { J.A = (const bf16_t*)(ws + 2 * SLOT); J.Bt = (const bf16_t*)(misc + OFF_WG); J.M = MT; J.N = DM; J.K = DM; J.mode = EPI_GATE; J.fo = (float*)(ws + 4 * SLOT); J.ss = (float*)(misc + OFF_SS) + 2 * MT;
           J.i0 = (const bf16_t*)(ws + 3 * SLOT); J.bias = P.in[23]; }
    return J;
}

__global__ void __launch_bounds__(512, 2) mega_fwd(Params P) {
    extern __shared__ __attribute__((aligned(16))) unsigned char lds_raw[];
    LAS unsigned char* lds = (LAS unsigned char*)lds_raw;
    cg::grid_group grid = cg::this_grid();
    const int G = gridDim.x;
    volatile LAS unsigned* stw = (volatile LAS unsigned*)(lds + 131072);
    if (threadIdx.x < 4) stw[threadIdx.x] = 0u;
    __syncthreads();
    const XcdBarrier xb = xcd_barrier_post((unsigned*)(P.ws + 7 * SLOT + OFF_BAR), stw);
    for (int ph = P.ph_lo; ph < P.ph_hi; ++ph) {
        if (ph > P.ph_lo) {
            if (P.ph_lo != 0) grid.sync();
            else xcd_barrier(xb);
        }
        int ngemm = 0;
        if (ph == 0) { if (PHMASK & 1) prologue(lds, P, G); }
        else if (ph == 2) { if (PHMASK & 2) gmlp_phase(lds, P, G); if (PHMASK & 4) attn_phase(lds, P, G); }
        else if (ph == 5) { if (PHMASK & 8) elementwise_phase(P, 0, G); }
        else if (ph == 8) { if (PHMASK & 8) elementwise_phase(P, 1, G); }
        else if (ph == 10) { if (PHMASK & 8) elementwise_phase(P, 2, G); }
        else ngemm = (ph == 1 || ph == 3 || ph == 9) ? 2 : 1;
        if (PHMASK & 16) for (int g = 0; g < ngemm; ++g) {
            const GemmJob J = make_job(P, ph, g);
            gemm_phase(lds, J, G, blockIdx.x);
        }
    }
}

extern "C" void kernel_launch(void* const* d_in, const int* in_sizes, int n_in, void* d_out, int out_size, void* d_ws, size_t ws_size, hipStream_t stream) {
    static int grid_blocks = 0;
    if (!grid_blocks) {
        int dev = 0, cus = 0, per_cu = 0;
        hipGetDevice(&dev);
        hipDeviceGetAttribute(&cus, hipDeviceAttributeMultiprocessorCount, dev);
        if (hipFuncSetAttribute((const void*)mega_fwd, hipFuncAttributeMaxDynamicSharedMemorySize, LDS_BYTES) != hipSuccess) fprintf(stderr, "hipFuncSetAttribute failed\n");
        hipOccupancyMaxActiveBlocksPerMultiprocessor(&per_cu, (const void*)mega_fwd, 512, LDS_BYTES);
        if (per_cu < 1) { fprintf(stderr, "occupancy query returned %d\n", per_cu); per_cu = 1; }
        grid_blocks = cus * per_cu;
        if (ws_size < 8 * SLOT) fprintf(stderr, "workspace too small: %zu\n", ws_size);
    }
    Params p{};
    for (int i = 0; i < 25; ++i) p.in[i] = (const float*)d_in[i];
    p.out = (float*)d_out; p.ws = (unsigned char*)d_ws; p.ph_lo = 0; p.ph_hi = NPHASE;
    if (hipMemsetAsync((char*)d_ws + 7 * SLOT + OFF_BAR, 0, 16384, stream) != hipSuccess) fprintf(stderr, "hipMemsetAsync of the barrier words failed\n");
    void* args[] = {&p};
    hipError_t e = hipLaunchCooperativeKernel((const void*)mega_fwd, dim3(grid_blocks), dim3(512), args, LDS_BYTES, stream);
    if (e != hipSuccess) fprintf(stderr, "cooperative launch failed: %s (grid %d)\n", hipGetErrorString(e), grid_blocks);
}
```

```cpp
#include <hip/hip_runtime.h>
#include <hip/hip_cooperative_groups.h>
#include <cstdio>
namespace cg = cooperative_groups;

#define LAS __attribute__((address_space(3)))
#define DI __device__ __forceinline__
typedef unsigned short bf16_t;
typedef short bf16x8 __attribute__((ext_vector_type(8)));
typedef float f32x4 __attribute__((ext_vector_type(4)));
typedef float f32x16 __attribute__((ext_vector_type(16)));
typedef unsigned u32x4 __attribute__((ext_vector_type(4)));
typedef unsigned u32x2 __attribute__((ext_vector_type(2)));

constexpr int MT = 65536, DM = 1024, SEQ = 8192, FFW = 4096, PLED = 256;
constexpr float EPSV = 1e-6f;
constexpr size_t SLOT = (size_t)1 << 27;
constexpr size_t OFF_WIN = 0;
constexpr size_t OFF_WVA = OFF_WIN + (size_t)6144 * 1024 * 2;
constexpr size_t OFF_WA = OFF_WVA + (size_t)1024 * 1024 * 2;
constexpr size_t OFF_WB = OFF_WA + (size_t)1024 * 1024 * 2;
constexpr size_t OFF_WO = OFF_WB + (size_t)1024 * 1024 * 2;
constexpr size_t OFF_WF1 = OFF_WO + (size_t)1024 * 1024 * 2;
constexpr size_t OFF_WF2 = OFF_WF1 + (size_t)4096 * 1024 * 2;
constexpr size_t OFF_WP = OFF_WF2 + (size_t)4096 * 1024 * 2;
constexpr size_t OFF_WG = OFF_WP + (size_t)1024 * 256 * 2;
constexpr size_t OFF_ROPE = OFF_WG + (size_t)1024 * 1024 * 2;
constexpr size_t OFF_SS = OFF_ROPE + (size_t)8192 * 32 * 8;
constexpr size_t OFF_WS = OFF_SS + (size_t)3 * 65536 * 4;
constexpr size_t OFF_PB = OFF_WS + (size_t)8 * 128 * 128 * 2;
constexpr size_t OFF_END = OFF_PB + (size_t)65536 * 256 * 2;
constexpr size_t OFF_BAR = OFF_END;
static_assert(OFF_BAR + 16384 <= SLOT, "misc region overflow");

constexpr int LDS_BYTES = 131072 + 16;
constexpr int NPHASE = 11;
#ifndef STAGGER_TICKS
#define STAGGER_TICKS 700
#endif
#ifndef PHMASK
#define PHMASK 31
#endif

struct Params {
    const float* in[25];
    float* out;
    unsigned char* ws;
    int ph_lo, ph_hi;
};

typedef __bf16 bf16x2n __attribute__((ext_vector_type(2)));
typedef float f32x2n __attribute__((ext_vector_type(2)));
DI unsigned cvt_pk_bf16(float lo, float hi) { const f32x2n v = {lo, hi}; return __builtin_bit_cast(unsigned, __builtin_convertvector(v, bf16x2n)); }
DI float bf_lo(unsigned w) { return __uint_as_float(w << 16); }
DI float bf_hi(unsigned w) { return __uint_as_float(w & 0xffff0000u); }
DI float fast_exp2(float x) { return __builtin_amdgcn_exp2f(x); }
DI float fast_rcp(float x) { return __builtin_amdgcn_rcpf(x); }
DI float sigmoid_f(float x) { return fast_rcp(1.0f + fast_exp2(-1.4426950408889634f * x)); }
DI float gelu_tanh(float x) { const float u = x * (0.7978845608028654f + 0.035677408136300125f * x * x); return x * fast_rcp(1.0f + fast_exp2(-2.885390081777927f * u)); }
DI int opaque_tid() { int t = threadIdx.x; asm volatile("" : "+v"(t)); return t; }
DI float xhalf_max(float x) { const auto r = __builtin_amdgcn_permlane32_swap(__float_as_uint(x), __float_as_uint(x), false, false); return fmaxf(__uint_as_float(r[0]), __uint_as_float(r[1])); }
DI float wave_sum(float v) { v += __shfl_xor(v, 32); v += __shfl_xor(v, 16); v += __shfl_xor(v, 8); v += __shfl_xor(v, 4); v += __shfl_xor(v, 2); v += __shfl_xor(v, 1); return v; }

constexpr int BM = 256, BK = 64, HALF = 128, HTB = HALF * BK * 2, NXCD = 8, WGM = 8;
DI int lds_byte(int r, int c) { const int st = (r >> 4) * 2 + (c >> 5), rr = r & 15, cc = c & 31, ob = rr * 64 + cc * 2; return st * 1024 + (ob ^ (((ob >> 9) & 1) << 5)); }
DI void stage_rc(int b, int& R, int& C) { const int st = b / 1024, sb = b % 1024, swz = sb ^ (((sb >> 9) & 1) << 5); R = (st >> 1) * 16 + swz / 64; C = (st & 1) * 32 + (swz % 64) / 2; }
DI int perm32(int rho) { const int n = rho >> 4, i = rho & 15; return 8 * (i >> 2) + 4 * n + (i & 3); }
struct Unit { int pm, pn; };
struct StaticOrder {
    int nM, nN, nwg, G, c;
    DI void init(int M, int N, int G_, int c_) { nM = M / BM; nN = N / BM; nwg = nM * nN; G = G_; c = c_; }
    DI bool next(int i, Unit& u) const {
        const long L = (long)i * G + c; if (L >= nwg) return false;
        int wgid = (int)L; { const int q = nwg / NXCD, r = nwg % NXCD, xcd = wgid % NXCD, off = wgid / NXCD; wgid = (xcd < r ? xcd * (q + 1) : r * (q + 1) + (xcd - r) * q) + off; }
        const int nig = WGM * nN, gid = wgid / nig, fm = gid * WGM, gsz = (nM - fm) < WGM ? (nM - fm) : WGM;
        u.pm = fm + ((wgid % nig) % gsz); u.pn = (wgid % nig) / gsz; return true;
    }
};

enum { EPI_IN = 0, EPI_BF16 = 1, EPI_BRA = 2, EPI_BRB = 3, EPI_RAW = 4, EPI_RELU2 = 5, EPI_GATE = 6, EPI_VT = 7 };
struct GemmJob {
    const bf16_t* A; const bf16_t* Bt; int M, N, K; int mode;
    bf16_t* o0; int ldc;
    const bf16_t* i0;
    float* fo; float* ss; const float* bias;
    bf16_t* in_base;
    bf16_t* gb_base;
    const float* rope;
};

constexpr float QSCALE = 0.125f * 1.4426950408889634f;

DI void epilogue(const f32x4 (&acc)[2][2][4][2], const Unit& u, int wr, int wc, int fr, int fq, const GemmJob& J) {
    const int mode = J.mode;
    if (mode == EPI_IN) {
        const int region = u.pn >> 2;
        bf16_t* base = region == 0 ? J.in_base : region == 1 ? J.in_base + (SLOT / 2) : region == 2 ? J.in_base + 2 * (SLOT / 2) : region == 3 ? J.in_base + 3 * (SLOT / 2)
                     : region == 4 ? J.in_base + 5 * (SLOT / 2) : J.gb_base;
        const int row0 = u.pm * BM + wr * 64 + fr, col0 = (u.pn & 3) * BM + wc * 32 + 8 * fq;
#pragma unroll
        for (int ai = 0; ai < 2; ++ai)
#pragma unroll
            for (int m = 0; m < 4; ++m) {
                const int row = row0 + ai * HALF + m * 16;
                bf16_t* rowp = base + (size_t)row * DM + col0;
                f32x4 t0 = {1.f, 0.f, 1.f, 0.f}, t1 = {1.f, 0.f, 1.f, 0.f};
                if (region == 2 || region == 3) {
                    const float* tp = J.rope + ((size_t)(row & (SEQ - 1)) * 32 + 16 * (wc & 1) + 4 * fq) * 2;
                    t0 = *(const f32x4*)tp; t1 = *(const f32x4*)(tp + 4);
                }
#pragma unroll
                for (int bj = 0; bj < 2; ++bj) {
                    f32x4 v0 = acc[ai][bj][m][0], v1 = acc[ai][bj][m][1];
                    if (region < 2) {
#pragma unroll
                        for (int j = 0; j < 4; ++j) { v0[j] = gelu_tanh(v0[j]); v1[j] = gelu_tanh(v1[j]); }
                    } else if (region < 4) {
                        const float sc = region == 2 ? QSCALE : 1.0f;
                        f32x4 a, b;
                        a[0] = (v0[0] * t0[0] - v0[1] * t0[1]) * sc; a[1] = (v0[1] * t0[0] + v0[0] * t0[1]) * sc;
                        a[2] = (v0[2] * t0[2] - v0[3] * t0[3]) * sc; a[3] = (v0[3] * t0[2] + v0[2] * t0[3]) * sc;
                        b[0] = (v1[0] * t1[0] - v1[1] * t1[1]) * sc; b[1] = (v1[1] * t1[0] + v1[0] * t1[1]) * sc;
                        b[2] = (v1[2] * t1[2] - v1[3] * t1[3]) * sc; b[3] = (v1[3] * t1[2] + v1[2] * t1[3]) * sc;
                        v0 = a; v1 = b;
                    } else {
#pragma unroll
                        for (int j = 0; j < 4; ++j) { v0[j] = sigmoid_f(v0[j]); v1[j] = sigmoid_f(v1[j]); }
                    }
                    u32x4 w; w.x = cvt_pk_bf16(v0[0], v0[1]); w.y = cvt_pk_bf16(v0[2], v0[3]); w.z = cvt_pk_bf16(v1[0], v1[1]); w.w = cvt_pk_bf16(v1[2], v1[3]);
                    if (region == 3) {
                        const size_t ko = ((size_t)((row >> 13) * 8 + (u.pn & 3) * 2 + bj) * SEQ + (row & (SEQ - 1))) * 128 + wc * 32 + 8 * fq;
                        *(u32x4*)(base + ko) = w;
                    } else *(u32x4*)(rowp + bj * HALF) = w;
                }
            }
    } else if (mode == EPI_BF16 || mode == EPI_RELU2 || mode == EPI_BRA || mode == EPI_BRB || mode == EPI_VT) {
        const bool widem = (mode == EPI_BRA || mode == EPI_BRB);
        const int wcs = widem ? 64 : 32, bjs = widem ? 32 : HALF;
        const int row0 = u.pm * BM + wr * 64 + fr, col0 = u.pn * BM + wc * wcs + 8 * fq;
#pragma unroll
        for (int ai = 0; ai < 2; ++ai)
#pragma unroll
            for (int m = 0; m < 4; ++m) {
                const size_t off = (size_t)(row0 + ai * HALF + m * 16) * J.ldc + col0;
#pragma unroll
                for (int bj = 0; bj < 2; ++bj) {
                    f32x4 v0 = acc[ai][bj][m][0], v1 = acc[ai][bj][m][1];
                    if (mode == EPI_RELU2) {
#pragma unroll
                        for (int j = 0; j < 4; ++j) { const float a = fmaxf(v0[j], 0.f), b = fmaxf(v1[j], 0.f); v0[j] = a * a; v1[j] = b * b; }
                    } else if (mode == EPI_BRA || mode == EPI_BRB) {
                        const u32x4 g = *(const u32x4*)(J.o0 + off + bj * bjs);
                        v0[0] *= bf_lo(g.x); v0[1] *= bf_hi(g.x); v0[2] *= bf_lo(g.y); v0[3] *= bf_hi(g.y);
                        v1[0] *= bf_lo(g.z); v1[1] *= bf_hi(g.z); v1[2] *= bf_lo(g.w); v1[3] *= bf_hi(g.w);
                        if (mode == EPI_BRB) {
                            const u32x4 t = *(const u32x4*)(J.i0 + off + bj * bjs);
                            v0[0] += bf_lo(t.x); v0[1] += bf_hi(t.x); v0[2] += bf_lo(t.y); v0[3] += bf_hi(t.y);
                            v1[0] += bf_lo(t.z); v1[1] += bf_hi(t.z); v1[2] += bf_lo(t.w); v1[3] += bf_hi(t.w);
                        }
                    }
                    u32x4 w; w.x = cvt_pk_bf16(v0[0], v0[1]); w.y = cvt_pk_bf16(v0[2], v0[3]); w.z = cvt_pk_bf16(v1[0], v1[1]); w.w = cvt_pk_bf16(v1[2], v1[3]);
                    if (mode == EPI_VT) {
                        const int feat = row0 + ai * HALF + m * 16, tok = col0 + bj * bjs;
                        const size_t vo = ((((size_t)((tok >> 13) * 8 + (feat >> 7)) * 128 + ((tok & (SEQ - 1)) >> 6)) * 128 + (feat & 127)) * 64) + (tok & 63);
                        *(u32x4*)(J.o0 + vo) = w;
                    } else
                    *(u32x4*)(J.o0 + off + bj * bjs) = w;
                }
            }
    } else {
        const int row0 = u.pm * BM + wr * 64 + fr, col0 = u.pn * BM + wc * 64 + 8 * fq;
#pragma unroll
        for (int ai = 0; ai < 2; ++ai)
#pragma unroll
            for (int m = 0; m < 4; ++m) {
                const int row = row0 + ai * HALF + m * 16;
                const size_t off = (size_t)row * DM + col0;
                float s = 0.f;
#pragma unroll
                for (int bj = 0; bj < 2; ++bj) {
                    f32x4 v0 = acc[ai][bj][m][0], v1 = acc[ai][bj][m][1];
                    if (mode == EPI_GATE) {
                        const f32x4 b0 = *(const f32x4*)(J.bias + col0 + bj * 32), b1 = *(const f32x4*)(J.bias + col0 + bj * 32 + 4);
                        const u32x4 e = *(const u32x4*)(J.i0 + off + bj * 32);
                        v0[0] = bf_lo(e.x) * sigmoid_f(v0[0] + b0[0]); v0[1] = bf_hi(e.x) * sigmoid_f(v0[1] + b0[1]);
                        v0[2] = bf_lo(e.y) * sigmoid_f(v0[2] + b0[2]); v0[3] = bf_hi(e.y) * sigmoid_f(v0[3] + b0[3]);
                        v1[0] = bf_lo(e.z) * sigmoid_f(v1[0] + b1[0]); v1[1] = bf_hi(e.z) * sigmoid_f(v1[1] + b1[1]);
                        v1[2] = bf_lo(e.w) * sigmoid_f(v1[2] + b1[2]); v1[3] = bf_hi(e.w) * sigmoid_f(v1[3] + b1[3]);
                    }
                    u32x4 w; w.x = cvt_pk_bf16(v0[0], v0[1]); w.y = cvt_pk_bf16(v0[2], v0[3]); w.z = cvt_pk_bf16(v1[0], v1[1]); w.w = cvt_pk_bf16(v1[2], v1[3]);
                    *(u32x4*)((bf16_t*)J.fo + off + bj * 32) = w;
                    s += ((v0[0] * v0[0] + v0[1] * v0[1]) + (v0[2] * v0[2] + v0[3] * v0[3])) + ((v1[0] * v1[0] + v1[1] * v1[1]) + (v1[2] * v1[2] + v1[3] * v1[3]));
                }
                s += __shfl_xor(s, 16); s += __shfl_xor(s, 32);
                if (fq == 0) atomicAdd(J.ss + row, s);
            }
    }
}

DI void gemm_phase(LAS unsigned char* lds, const GemmJob& J, int G, int cidx) {
    const int tid = opaque_tid(), wid = __builtin_amdgcn_readfirstlane(tid >> 6), lane = tid & 63, wr = wid >> 2, wc = wid & 3, fr = lane & 15, fq = lane >> 4;
    const int K = J.K, nt = K / BK;
    const bool perm = true;
    const bool wide = (J.mode == EPI_BRA || J.mode == EPI_BRB || J.mode == EPI_RAW || J.mode == EPI_GATE);
    StaticOrder S; S.init(J.M, J.N, G, cidx);
    unsigned voffA[2], voffB[2];
#pragma unroll
    for (int i = 0; i < 2; ++i) { int R, C; stage_rc(tid * 16 + i * 8192, R, C); const int Rb = perm ? ((R & ~31) + perm32(R & 31)) : R;
        const int Rw = 64 * (R >> 5) + perm32(R & 31);
        voffA[i] = (unsigned)(R * K + C) * 2u; voffB[i] = (unsigned)((wide ? Rw : Rb) * K + C) * 2u; }
    const size_t kstep = (size_t)(BK * 2);
    const size_t hstep = (size_t)HALF * K * 2;
    const size_t tstep = 2 * hstep;
    const size_t hstepB = wide ? (size_t)32 * K * 2 : hstep;
    const unsigned ldsw = (unsigned)wid * 1024u;
    const int aoff = lds_byte(wr * 64 + fr, fq * 8), boff = lds_byte(wc * 32 + fr, fq * 8);
#define PG8_SA(b, h) (((b) * 2 + (h)) * HTB)
#define PG8_SB(b, h) ((4 + (b) * 2 + (h)) * HTB)
#define PG8_STAGE(bufoff, gbase, voff) do { _Pragma("unroll") for (int _i = 0; _i < 2; ++_i) \
        __builtin_amdgcn_global_load_lds((const unsigned*)((const char*)(gbase) + (voff)[_i]), (LAS unsigned*)(lds + (bufoff) + ldsw + _i * 8192), 16, 0, 0); } while (0)
#define PG8_LDA(dst, b, h) do { _Pragma("unroll") for (int m = 0; m < 4; ++m) _Pragma("unroll") for (int k = 0; k < 2; ++k) dst[m][k] = *(const LAS bf16x8*)(lds + PG8_SA(b, h) + aoff + m * 2048 + k * 1024); } while (0)
#define PG8_LDB(dst, b, h) do { _Pragma("unroll") for (int n = 0; n < 2; ++n) _Pragma("unroll") for (int k = 0; k < 2; ++k) dst[n][k] = *(const LAS bf16x8*)(lds + PG8_SB(b, h) + boff + n * 2048 + k * 1024); } while (0)
#define PG8_MMA(ai, bj, At, Bt) do { __builtin_amdgcn_s_setprio(1); _Pragma("unroll") for (int m = 0; m < 4; ++m) _Pragma("unroll") for (int n = 0; n < 2; ++n) _Pragma("unroll") for (int k = 0; k < 2; ++k) \
        acc[ai][bj][m][n] = __builtin_amdgcn_mfma_f32_16x16x32_bf16(Bt[n][k], At[m][k], acc[ai][bj][m][n], 0, 0, 0); __builtin_amdgcn_s_setprio(0); } while (0)
#define PG8_WAIT_V(n) asm volatile("s_waitcnt vmcnt(" #n ")" ::: "memory")
#define PG8_WAIT_L(n) asm volatile("s_waitcnt lgkmcnt(" #n ")" ::: "memory")
#define PG8_BAR __builtin_amdgcn_s_barrier()
#define PG8_SCHED __builtin_amdgcn_sched_barrier(0)
    Unit cur, nxt; int ui = 0;
    if (!S.next(0, cur)) return;
    f32x4 acc[2][2][4][2];
#pragma unroll
    for (int a = 0; a < 2; ++a)
#pragma unroll
        for (int b = 0; b < 2; ++b)
#pragma unroll
            for (int m = 0; m < 4; ++m)
#pragma unroll
                for (int n = 0; n < 2; ++n) acc[a][b][m][n] = (f32x4){0.f, 0.f, 0.f, 0.f};
    bf16x8 At[4][2], B0[2][2], B1[2][2];
    const char* cA = (const char*)J.A + (size_t)cur.pm * tstep; const char* cB = (const char*)J.Bt + (size_t)cur.pn * tstep;
    PG8_STAGE(PG8_SB(0, 0), cB, voffB); PG8_STAGE(PG8_SA(0, 0), cA, voffA); PG8_STAGE(PG8_SB(0, 1), cB + hstepB, voffB); PG8_STAGE(PG8_SA(0, 1), cA + hstep, voffA);
    if (wr == 1) PG8_BAR;
    PG8_WAIT_V(4); PG8_BAR;
    PG8_STAGE(PG8_SB(1, 0), cB + kstep, voffB); PG8_STAGE(PG8_SA(1, 0), cA + kstep, voffA); PG8_STAGE(PG8_SB(1, 1), cB + hstepB + kstep, voffB);
    PG8_WAIT_V(6); PG8_BAR;
    for (;;) {
        const bool has_next = S.next(ui + 1, nxt);
        const char* nA = has_next ? (const char*)J.A + (size_t)nxt.pm * tstep : cA; const char* nB = has_next ? (const char*)J.Bt + (size_t)nxt.pn * tstep : cB;
        for (int t = 0; t < nt; t += 2) {
            const bool last = (t == nt - 2);
            const char* a1 = cA + (size_t)(t + 1) * kstep;
            const char* a2 = last ? nA : cA + (size_t)(t + 2) * kstep; const char* b2 = last ? nB : cB + (size_t)(t + 2) * kstep;
            const char* a3 = a2 + kstep; const char* b3 = b2 + kstep;
            PG8_LDB(B0, 0, 0); PG8_SCHED; PG8_LDA(At, 0, 0); PG8_STAGE(PG8_SA(1, 1), a1 + hstep, voffA);
            PG8_WAIT_L(8); PG8_BAR; PG8_WAIT_L(0); PG8_MMA(0, 0, At, B0); PG8_BAR; PG8_SCHED;
            PG8_LDB(B1, 0, 1); PG8_STAGE(PG8_SB(0, 0), b2, voffB);
            PG8_BAR; PG8_WAIT_L(0); PG8_MMA(0, 1, At, B1); PG8_BAR;
            PG8_LDA(At, 0, 1); PG8_STAGE(PG8_SA(0, 0), a2, voffA);
            PG8_BAR; PG8_WAIT_L(0); PG8_MMA(1, 0, At, B0); PG8_BAR; PG8_SCHED;
            PG8_STAGE(PG8_SB(0, 1), b2 + hstepB, voffB);
            PG8_WAIT_V(6); PG8_BAR; PG8_MMA(1, 1, At, B1); PG8_BAR;
            PG8_LDB(B0, 1, 0); PG8_SCHED; PG8_LDA(At, 1, 0); PG8_STAGE(PG8_SA(0, 1), a2 + hstep, voffA);
            PG8_WAIT_L(8); PG8_BAR; PG8_WAIT_L(0); PG8_MMA(0, 0, At, B0); PG8_BAR; PG8_SCHED;
            PG8_LDB(B1, 1, 1); PG8_STAGE(PG8_SB(1, 0), b3, voffB);
            PG8_BAR; PG8_WAIT_L(0); PG8_MMA(0, 1, At, B1); PG8_BAR;
            PG8_LDA(At, 1, 1); PG8_STAGE(PG8_SA(1, 0), a3, voffA);
            PG8_BAR; PG8_WAIT_L(0); PG8_MMA(1, 0, At, B0); PG8_BAR; PG8_SCHED;
            PG8_STAGE(PG8_SB(1, 1), b3 + hstepB, voffB);
            PG8_WAIT_V(6); PG8_BAR; PG8_MMA(1, 1, At, B1); PG8_BAR;
        }
        epilogue(acc, cur, wr, wc, fr, fq, J);
        if (!has_next) break;
#pragma unroll
        for (int a = 0; a < 2; ++a)
#pragma unroll
            for (int b = 0; b < 2; ++b)
#pragma unroll
                for (int m = 0; m < 4; ++m)
#pragma unroll
                    for (int n = 0; n < 2; ++n) acc[a][b][m][n] = (f32x4){0.f, 0.f, 0.f, 0.f};
        cur = nxt; cA = nA; cB = nB; ++ui;
    }
    PG8_WAIT_V(0);
    if (wr == 0) PG8_BAR;
    PG8_BAR;
#undef PG8_SA
#undef PG8_SB
#undef PG8_STAGE
#undef PG8_LDA
#undef PG8_LDB
#undef PG8_MMA
#undef PG8_WAIT_V
#undef PG8_WAIT_L
#undef PG8_BAR
#undef PG8_SCHED
}

DI bf16_t* win_dstrow(int sc, bf16_t* win_t, bf16_t* wva_t) {
    if (sc < 2048) return win_t + (size_t)sc * DM;
    if (sc < 4096) { const int g = sc & ~63, d = sc & 63, p = ((d & 31) << 1) | (d >> 5); return win_t + (size_t)(g + p) * DM; }
    if (sc < 5120) return wva_t + (size_t)(sc - 4096) * DM;
    return win_t + (size_t)(sc - 1024) * DM;
}
struct TJob { const float* src; int Kdim, Ncols, tk, tn, mode; bf16_t* dst; bf16_t* dst2; };
DI TJob tjob(const Params& P, unsigned char* misc, int t) {
    TJob j; j.mode = 0; j.dst2 = nullptr;
    if (t < 1792) { j.src = P.in[3]; j.Kdim = 1024; j.Ncols = 7168; j.tk = t / 112; j.tn = t % 112; j.mode = 1; j.dst = (bf16_t*)(misc + OFF_WIN); j.dst2 = (bf16_t*)(misc + OFF_WVA); }
    else if (t < 2560) { const int q = t - 1792, w = q >> 8, tt = q & 255; j.src = w == 0 ? P.in[13] : w == 1 ? P.in[14] : P.in[15];
        j.dst = (bf16_t*)(misc + (w == 0 ? OFF_WA : w == 1 ? OFF_WB : OFF_WO)); j.Kdim = 1024; j.Ncols = 1024; j.tk = tt >> 4; j.tn = tt & 15; }
    else if (t < 3584) { const int q = t - 2560; j.src = P.in[18]; j.Kdim = 1024; j.Ncols = 4096; j.tk = q >> 6; j.tn = q & 63; j.dst = (bf16_t*)(misc + OFF_WF1); }
    else if (t < 4608) { const int q = t - 3584; j.src = P.in[19]; j.Kdim = 4096; j.Ncols = 1024; j.tk = q >> 4; j.tn = q & 15; j.dst = (bf16_t*)(misc + OFF_WF2); }
    else if (t < 4672) { const int q = t - 4608; j.src = P.in[21]; j.Kdim = 256; j.Ncols = 1024; j.tk = q >> 4; j.tn = q & 15; j.dst = (bf16_t*)(misc + OFF_WP); }
    else { const int q = t - 4672; j.src = P.in[22]; j.Kdim = 1024; j.Ncols = 1024; j.tk = q >> 4; j.tn = q & 15; j.dst = (bf16_t*)(misc + OFF_WG); }
    return j;
}
DI void tconv_load(const TJob& j, int tid, f32x4 (&v)[2]) {
    const int c4 = (tid & 15) * 4, r = tid >> 4;
#pragma unroll
    for (int i = 0; i < 2; ++i) v[i] = *(const f32x4*)(j.src + (size_t)(j.tk * 64 + r + 32 * i) * j.Ncols + j.tn * 64 + c4);
}
DI void tconv_finish(LAS float* tile, const TJob& j, int tid, const f32x4 (&v)[2]) {
    const int k0 = j.tk * 64, c0 = j.tn * 64;
    {
        const int c4 = (tid & 15) * 4, r = tid >> 4;
#pragma unroll
        for (int i = 0; i < 2; ++i) {
            const int rr = r + 32 * i;
            tile[(c4 + 0) * 65 + rr] = v[i][0]; tile[(c4 + 1) * 65 + rr] = v[i][1]; tile[(c4 + 2) * 65 + rr] = v[i][2]; tile[(c4 + 3) * 65 + rr] = v[i][3];
        }
    }
    asm volatile("s_waitcnt lgkmcnt(0)" ::: "memory"); __builtin_amdgcn_s_barrier(); asm volatile("" ::: "memory");
    {
        const int cc = tid >> 3, r8 = (tid & 7) * 8;
        float f[8];
#pragma unroll
        for (int q = 0; q < 8; ++q) f[q] = tile[cc * 65 + r8 + q];
        u32x4 w; w.x = cvt_pk_bf16(f[0], f[1]); w.y = cvt_pk_bf16(f[2], f[3]); w.z = cvt_pk_bf16(f[4], f[5]); w.w = cvt_pk_bf16(f[6], f[7]);
        bf16_t* rowp = j.mode == 1 ? win_dstrow(c0 + cc, j.dst, j.dst2) : j.dst + (size_t)(c0 + cc) * j.Kdim;
        *(u32x4*)(rowp + k0 + r8) = w;
    }
}

DI void prologue(LAS unsigned char* lds, const Params& P, int G) {
    unsigned char* misc = P.ws + 7 * SLOT;
    const int tid = opaque_tid(), lane = tid & 63, wid = tid >> 6;
    {
        int t = blockIdx.x; int par = 0;
        TJob cur = tjob(P, misc, t); f32x4 v[2]; tconv_load(cur, tid, v);
        while (t < 4928) {
            const int tn_ = t + G; const bool hn = tn_ < 4928;
            TJob nx = cur; f32x4 vn[2] = {v[0], v[1]};
            if (hn) { nx = tjob(P, misc, tn_); tconv_load(nx, tid, vn); }
            tconv_finish((LAS float*)(lds + par * 16640), cur, tid, v);
            cur = nx; v[0] = vn[0]; v[1] = vn[1]; t = tn_; par ^= 1;
        }
        __syncthreads();
    }
    const size_t gtid = (size_t)blockIdx.x * 512 + tid, gthreads = (size_t)G * 512;
    {
        float* rope = (float*)(misc + OFF_ROPE);
        for (size_t i = gtid; i < (size_t)SEQ * 32; i += gthreads) {
            const int pos = (int)(i >> 5), f = (int)(i & 31);
            const float inv = 1.0f / powf(10000.0f, (float)(2 * f) / 64.0f);
            const float ang = (float)pos * inv;
            const double a = (double)ang; const double kq = __builtin_rint(a * 0.15915494309189535); const float rr = (float)(a - kq * 6.283185307179586);
            rope[2 * i] = cosf(rr); rope[2 * i + 1] = sinf(rr);
        }
    }
    { float* ss = (float*)(misc + OFF_SS); for (size_t i = gtid; i < (size_t)3 * MT; i += gthreads) ss[i] = 0.f; }
    {
        bf16_t* wsb = (bf16_t*)(misc + OFF_WS); const float* w = P.in[6];
        for (size_t i = gtid; i < (size_t)8 * 128 * 128; i += gthreads) {
            const int s = (int)(i & 127), t = (int)((i >> 7) & 127);
            const float v = ((s >> 6) <= (t >> 6)) ? w[i] : 0.f;
            wsb[i] = (bf16_t)(cvt_pk_bf16(v, 0.f) & 0xffffu);
        }
    }
    {
        const f32x4* p4 = (const f32x4*)P.in[1]; u32x2* pb = (u32x2*)(misc + OFF_PB);
        for (size_t i = gtid; i < (size_t)MT * PLED / 4; i += gthreads) { const f32x4 v = p4[i]; u32x2 w; w.x = cvt_pk_bf16(v[0], v[1]); w.y = cvt_pk_bf16(v[2], v[3]); pb[i] = w; }
    }
    {
        const float* x = P.in[0]; const float* g = P.in[2]; bf16_t* xn = (bf16_t*)(P.ws);
        f32x4 gv[4];
#pragma unroll
        for (int i = 0; i < 4; ++i) gv[i] = *(const f32x4*)(g + 256 * i + lane * 4);
        for (int row = blockIdx.x * 8 + wid; row < MT; row += G * 8) {
            f32x4 v[4]; float s = 0.f;
#pragma unroll
            for (int i = 0; i < 4; ++i) { v[i] = *(const f32x4*)(x + (size_t)row * DM + 256 * i + lane * 4); s += (v[i][0] * v[i][0] + v[i][1] * v[i][1]) + (v[i][2] * v[i][2] + v[i][3] * v[i][3]); }
            s = wave_sum(s);
            const float rs = rsqrtf(s * (1.0f / DM) + EPSV);
#pragma unroll
            for (int i = 0; i < 4; ++i) { u32x2 w; w.x = cvt_pk_bf16(v[i][0] * rs * gv[i][0], v[i][1] * rs * gv[i][1]); w.y = cvt_pk_bf16(v[i][2] * rs * gv[i][2], v[i][3] * rs * gv[i][3]);
                *(u32x2*)(xn + (size_t)row * DM + 256 * i + lane * 4) = w; }
        }
    }
}

DI void elementwise_phase(const Params& P, int which, int G) {
    unsigned char* misc = P.ws + 7 * SLOT;
    const int tid = opaque_tid(), lane = tid & 63, wid = tid >> 6;
    const float* ssb = (const float*)(misc + OFF_SS) + (size_t)which * MT;
    bf16_t* H = (bf16_t*)P.ws;
    const bf16_t* raw = which == 0 ? (const bf16_t*)(P.ws + 2 * SLOT) : which == 1 ? (const bf16_t*)P.out : (const bf16_t*)(P.ws + 4 * SLOT);
    const float* g1 = which == 0 ? P.in[16] : which == 1 ? P.in[20] : P.in[24];
    bf16_t* dstb = which == 0 ? (bf16_t*)P.out : (bf16_t*)(P.ws + 2 * SLOT);
    f32x4 gv[4], g2[4];
#pragma unroll
    for (int i = 0; i < 4; ++i) { const int col = 512 * (i >> 1) + lane * 8 + 4 * (i & 1); gv[i] = *(const f32x4*)(g1 + col); g2[i] = which == 0 ? *(const f32x4*)(P.in[17] + col) : (f32x4){1.f, 1.f, 1.f, 1.f}; }
    for (int row = blockIdx.x * 8 + wid; row < MT; row += G * 8) {
        const float rs = rsqrtf(ssb[row] * (1.0f / DM) + EPSV);
        f32x4 h[4]; float s = 0.f;
#pragma unroll
        for (int c = 0; c < 2; ++c) {
            const size_t o = (size_t)row * DM + 512 * c + lane * 8;
            f32x4 b0, b1;
            if (which == 0) { b0 = *(const f32x4*)(P.in[0] + o); b1 = *(const f32x4*)(P.in[0] + o + 4); }
            else { const u32x4 hw = *(const u32x4*)(H + o); b0 = (f32x4){bf_lo(hw.x), bf_hi(hw.x), bf_lo(hw.y), bf_hi(hw.y)}; b1 = (f32x4){bf_lo(hw.z), bf_hi(hw.z), bf_lo(hw.w), bf_hi(hw.w)}; }
            const u32x4 rw = *(const u32x4*)(raw + o);
            const f32x4 r0 = {bf_lo(rw.x), bf_hi(rw.x), bf_lo(rw.y), bf_hi(rw.y)}, r1 = {bf_lo(rw.z), bf_hi(rw.z), bf_lo(rw.w), bf_hi(rw.w)};
            h[2 * c] = b0 + r0 * rs * gv[2 * c]; h[2 * c + 1] = b1 + r1 * rs * gv[2 * c + 1];
        }
#pragma unroll
        for (int i = 0; i < 4; ++i) s += (h[i][0] * h[i][0] + h[i][1] * h[i][1]) + (h[i][2] * h[i][2] + h[i][3] * h[i][3]);
        float rs2 = 1.0f;
        if (which == 0) { s = wave_sum(s); rs2 = rsqrtf(s * (1.0f / DM) + EPSV); }
#pragma unroll
        for (int c = 0; c < 2; ++c) {
            const size_t o = (size_t)row * DM + 512 * c + lane * 8;
            const f32x4 h0 = h[2 * c], h1 = h[2 * c + 1];
            if (which == 2) { *(f32x4*)(P.out + o) = h0; *(f32x4*)(P.out + o + 4) = h1; }
            else {
                u32x4 hw; hw.x = cvt_pk_bf16(h0[0], h0[1]); hw.y = cvt_pk_bf16(h0[2], h0[3]); hw.z = cvt_pk_bf16(h1[0], h1[1]); hw.w = cvt_pk_bf16(h1[2], h1[3]);
                *(u32x4*)(H + o) = hw;
                if (which == 0) { const f32x4 a0 = h0 * rs2 * g2[2 * c], a1 = h1 * rs2 * g2[2 * c + 1];
                    u32x4 w; w.x = cvt_pk_bf16(a0[0], a0[1]); w.y = cvt_pk_bf16(a0[2], a0[3]); w.z = cvt_pk_bf16(a1[0], a1[1]); w.w = cvt_pk_bf16(a1[2], a1[3]); *(u32x4*)(dstb + o) = w; }
                else *(u32x4*)(dstb + o) = hw;
            }
        }
    }
}

typedef short s16x4 __attribute__((ext_vector_type(4)));
DI void gmlp_phase(LAS unsigned char* lds, const Params& P, int G) {
    unsigned char* misc = P.ws + 7 * SLOT;
    const int tid = opaque_tid(), lane = tid & 63, wid = tid >> 6, fr = lane & 15, fq = lane >> 4;
    bf16_t* U = (bf16_t*)(P.ws + 1 * SLOT); const bf16_t* V = (const bf16_t*)(P.ws + 2 * SLOT);
    const bf16_t* WS = (const bf16_t*)(misc + OFF_WS);
    const float* lng = P.in[4]; const float* lnb = P.in[5]; const float* bs = P.in[7];
    LAS float* st = (LAS float*)lds;
    LAS unsigned char* vs = lds + 1024;
    constexpr int PV = 272;
    const int trq = fr >> 2, trp = fr & 3;
    for (int blk = blockIdx.x; blk < MT / 128; blk += G) {
        const size_t tok0 = (size_t)blk * 128;
        for (int r4 = 0; r4 < 4; ++r4) {
            float sm[4], sq[4];
#pragma unroll
            for (int e = 0; e < 4; ++e) {
                const bf16_t* vp = V + (tok0 + wid * 16 + r4 * 4 + e) * DM;
                const u32x4 a = *(const u32x4*)(vp + lane * 8), b2 = *(const u32x4*)(vp + 512 + lane * 8);
                float s0 = 0.f, q0 = 0.f;
#pragma unroll
                for (int j = 0; j < 4; ++j) { const float x0 = bf_lo(a[j]), x1 = bf_hi(a[j]), y0 = bf_lo(b2[j]), y1 = bf_hi(b2[j]); s0 += (x0 + x1) + (y0 + y1); q0 += (x0 * x0 + x1 * x1) + (y0 * y0 + y1 * y1); }
                sm[e] = s0; sq[e] = q0;
            }
#pragma unroll
            for (int o = 32; o >= 1; o >>= 1) {
#pragma unroll
                for (int e = 0; e < 4; ++e) { sm[e] += __shfl_xor(sm[e], o); sq[e] += __shfl_xor(sq[e], o); }
            }
            if (lane < 4) {
                const float s0 = lane == 0 ? sm[0] : lane == 1 ? sm[1] : lane == 2 ? sm[2] : sm[3];
                const float q0 = lane == 0 ? sq[0] : lane == 1 ? sq[1] : lane == 2 ? sq[2] : sq[3];
                const float mu = s0 * (1.0f / DM); const float var = fmaxf(q0 * (1.0f / DM) - mu * mu, 0.f);
                const int row = wid * 16 + r4 * 4 + lane; st[row * 2] = mu; st[row * 2 + 1] = rsqrtf(var + EPSV);
            }
        }
        u32x4 vreg[4];
#pragma unroll
        for (int i = 0; i < 4; ++i) { const int id = tid + 512 * i; vreg[i] = *(const u32x4*)(V + (tok0 + (id >> 4)) * DM + (id & 15) * 8); }
        u32x4 unext[4];
#pragma unroll
        for (int np = 0; np < 4; ++np) unext[np] = *(const u32x4*)(U + (tok0 + 16 * wid + fr) * DM + 32 * np + 8 * fq);
        __syncthreads();
        for (int g = 0; g < 8; ++g) {
#pragma unroll
            for (int i = 0; i < 4; ++i) {
                const int id = tid + 512 * i, sr = id >> 4, cc = (id & 15) * 8;
                const u32x4 v = vreg[i];
                const float mu = st[2 * sr], rs = st[2 * sr + 1];
                const f32x4 ga = *(const f32x4*)(lng + g * 128 + cc), gb = *(const f32x4*)(lng + g * 128 + cc + 4);
                const f32x4 ba = *(const f32x4*)(lnb + g * 128 + cc), bb = *(const f32x4*)(lnb + g * 128 + cc + 4);
                u32x4 w;
                w.x = cvt_pk_bf16((bf_lo(v.x) - mu) * rs * ga[0] + ba[0], (bf_hi(v.x) - mu) * rs * ga[1] + ba[1]);
                w.y = cvt_pk_bf16((bf_lo(v.y) - mu) * rs * ga[2] + ba[2], (bf_hi(v.y) - mu) * rs * ga[3] + ba[3]);
                w.z = cvt_pk_bf16((bf_lo(v.z) - mu) * rs * gb[0] + bb[0], (bf_hi(v.z) - mu) * rs * gb[1] + bb[1]);
                w.w = cvt_pk_bf16((bf_lo(v.w) - mu) * rs * gb[2] + bb[2], (bf_hi(v.w) - mu) * rs * gb[3] + bb[3]);
                *(LAS u32x4*)(vs + sr * PV + cc * 2) = w;
            }
            if (g < 7) {
#pragma unroll
                for (int i = 0; i < 4; ++i) { const int id = tid + 512 * i; vreg[i] = *(const u32x4*)(V + (tok0 + (id >> 4)) * DM + (g + 1) * 128 + (id & 15) * 8); }
            }
            const int t = 16 * wid + fr;
            bf16x8 wa[4];
#pragma unroll
            for (int kk = 0; kk < 4; ++kk) wa[kk] = *(const bf16x8*)(WS + (size_t)(g * 128 + t) * 128 + 32 * kk + 8 * fq);
            u32x4 uu[4];
#pragma unroll
            for (int np = 0; np < 4; ++np) uu[np] = unext[np];
            if (g < 7) {
#pragma unroll
                for (int np = 0; np < 4; ++np) unext[np] = *(const u32x4*)(U + (tok0 + t) * DM + (g + 1) * 128 + 32 * np + 8 * fq);
            }
            const float bsv = bs[g * 128 + t];
            __syncthreads();
            f32x4 acc[8];
#pragma unroll
            for (int n = 0; n < 8; ++n) acc[n] = (f32x4){0.f, 0.f, 0.f, 0.f};
#pragma unroll
            for (int kk = 0; kk < 4; ++kk) {
#pragma unroll
                for (int n = 0; n < 8; ++n) {
                    LAS unsigned char* ap = vs + (32 * kk + 8 * fq + trq) * PV + 64 * (n >> 1) + 16 * trp + 8 * (n & 1);
                    const s16x4 lo = __builtin_amdgcn_ds_read_tr16_b64_v4i16((LAS s16x4*)ap);
                    const s16x4 hi = __builtin_amdgcn_ds_read_tr16_b64_v4i16((LAS s16x4*)(ap + 4 * PV));
                    const bf16x8 bfr = __builtin_shufflevector(lo, hi, 0, 1, 2, 3, 4, 5, 6, 7);
                    acc[n] = __builtin_amdgcn_mfma_f32_16x16x32_bf16(bfr, wa[kk], acc[n], 0, 0, 0);
                }
            }
#pragma unroll
            for (int np = 0; np < 4; ++np) {
                bf16_t* up = U + (tok0 + t) * DM + g * 128 + 32 * np + 8 * fq;
                const f32x4 a0 = acc[2 * np], a1 = acc[2 * np + 1]; const u32x4 u4 = uu[np];
                u32x4 w;
                w.x = cvt_pk_bf16(bf_lo(u4.x) * (a0[0] + bsv), bf_hi(u4.x) * (a0[1] + bsv)); w.y = cvt_pk_bf16(bf_lo(u4.y) * (a0[2] + bsv), bf_hi(u4.y) * (a0[3] + bsv));
                w.z = cvt_pk_bf16(bf_lo(u4.z) * (a1[0] + bsv), bf_hi(u4.z) * (a1[1] + bsv)); w.w = cvt_pk_bf16(bf_lo(u4.w) * (a1[2] + bsv), bf_hi(u4.w) * (a1[3] + bsv));
                *(u32x4*)up = w;
            }
            __syncthreads();
        }
    }
}

constexpr int ATT_KBUF = 16384, ATT_KCOMP = 8192, ATT_VBASE = 4 * ATT_KBUF, ATT_VBUF = 16384, ATT_XOFF = 0;
DI bf16x8 pack8(const f32x16& s, int b) {
    u32x4 p; p.x = cvt_pk_bf16(s[b + 0], s[b + 1]); p.y = cvt_pk_bf16(s[b + 2], s[b + 3]); p.z = cvt_pk_bf16(s[b + 4], s[b + 5]); p.w = cvt_pk_bf16(s[b + 6], s[b + 7]);
    return __builtin_bit_cast(bf16x8, p);
}
DI bf16x8 att_kfrag(LAS const unsigned char* Kb, int rowoff, int kk, int yb) { return *(LAS const bf16x8*)(Kb + rowoff + ((32 * kk) ^ yb)); }
DI bf16x8 att_vfrag(LAS const unsigned char* Vb, int d, int rowoff, int ks, int yb) { return *(LAS const bf16x8*)(Vb + d * 4096 + rowoff + ((32 * ks) ^ yb)); }
DI float att_rowmax1(const f32x16& S) {
    float mx = fmaxf(S[0], S[1]);
#pragma unroll
    for (int i = 2; i < 16; i += 2) mx = fmaxf(fmaxf(mx, S[i]), S[i + 1]);
    return xhalf_max(mx);
}
template <bool HAS_NEXT>
DI void att_half(f32x16& C, f32x16& N, f32x16 (&o)[4], const bf16x8 (&qf)[4], f32x16& negm, float& lrun, float& cmx,
                 LAS const unsigned char* Kn, LAS const unsigned char* Vb, int ks0, int kro, int kyb, int vro, int vyb) {
    if (__builtin_amdgcn_ballot_w64(cmx > 6.0f) != 0ull) {
        const float dlt = fmaxf(cmx, 0.f); const float sc = fast_exp2(-dlt); lrun *= sc;
#pragma unroll
        for (int i = 0; i < 16; ++i) { C[i] -= dlt; negm[i] -= dlt; }
#pragma unroll
        for (int d = 0; d < 4; ++d)
#pragma unroll
            for (int i = 0; i < 16; ++i) o[d][i] *= sc;
    }
    float ps = 0.f;
    bf16x8 vf[4];
    if (HAS_NEXT) {
        bf16x8 kf[2];
        kf[0] = att_kfrag(Kn, kro, 0, kyb);
#pragma unroll
        for (int kk = 0; kk < 4; ++kk) {
            if (kk < 3) kf[(kk + 1) & 1] = att_kfrag(Kn, kro, kk + 1, kyb);
            if (kk == 3) {
#pragma unroll
                for (int d = 0; d < 4; ++d) vf[d] = att_vfrag(Vb, d, vro, ks0, vyb);
            }
            N = __builtin_amdgcn_mfma_f32_32x32x16_bf16(kf[kk & 1], qf[kk], kk == 0 ? negm : N, 0, 0, 0);
#pragma unroll
            for (int i = 4 * kk; i < 4 * kk + 4; ++i) { C[i] = fast_exp2(C[i]); ps += C[i]; }
            __builtin_amdgcn_sched_barrier(0);
        }
    } else {
#pragma unroll
        for (int d = 0; d < 4; ++d) vf[d] = att_vfrag(Vb, d, vro, ks0, vyb);
#pragma unroll
        for (int i = 0; i < 16; ++i) { C[i] = fast_exp2(C[i]); ps += C[i]; }
    }
    lrun += ps;
    bf16x8 pf[2]; pf[0] = pack8(C, 0); pf[1] = pack8(C, 8);
#pragma unroll
    for (int d = 0; d < 4; ++d) o[d] = __builtin_amdgcn_mfma_f32_32x32x16_bf16(vf[d], pf[0], o[d], 0, 0, 0);
    __builtin_amdgcn_sched_barrier(0);
    bf16x8 vg[4];
#pragma unroll
    for (int d = 0; d < 4; ++d) vg[d] = att_vfrag(Vb, d, vro, ks0 + 1, vyb);
    if (HAS_NEXT) {
        float pm = fmaxf(N[0], N[1]);
#pragma unroll
        for (int i = 2; i < 16; i += 2) pm = fmaxf(fmaxf(pm, N[i]), N[i + 1]);
        cmx = xhalf_max(pm);
    }
#pragma unroll
    for (int d = 0; d < 4; ++d) o[d] = __builtin_amdgcn_mfma_f32_32x32x16_bf16(vg[d], pf[1], o[d], 0, 0, 0);
    __builtin_amdgcn_sched_barrier(0);
}
#define ATT_DMA_K(KT, BUF) do { _Pragma("unroll") for (int i = 0; i < 2; ++i) \
    __builtin_amdgcn_global_load_lds((const unsigned*)(kgp[i] + (size_t)(KT) * 64 * 128), (LAS unsigned*)(lds + (BUF) * ATT_KBUF + (wid * 2 + i) * 1024), 16, 0, 0); } while (0)
#define ATT_DMA_V(KT, BUF) do { _Pragma("unroll") for (int i = 0; i < 2; ++i) \
    __builtin_amdgcn_global_load_lds((const unsigned*)(vgp[i] + (size_t)(KT) * 8192), (LAS unsigned*)(lds + ATT_VBASE + (BUF) * ATT_VBUF + (wid * 2 + i) * 1024), 16, 0, 0); } while (0)

DI void att_tile_id(int idx, int G, int& b, int& h, int& qt) {
    const int u = blockIdx.x + (idx >> 1) * G;
    const int k = u / 256, w = u % 256, bh = k * 8 + (w & 7), j = w >> 3;
    b = bh >> 3; h = bh & 7; qt = (idx & 1) ? j : 63 - j;
}
DI void attn_phase(LAS unsigned char* lds, const Params& P, int G) {
    const bf16_t* Qg = (const bf16_t*)(P.ws + 3 * SLOT); const bf16_t* Kg = (const bf16_t*)(P.ws + 4 * SLOT); const bf16_t* Vtg = (const bf16_t*)(P.ws + 5 * SLOT);
    bf16_t* Og = (bf16_t*)(P.ws + 3 * SLOT);
    const float* subg = P.in[12];
    float d1 = 0.f, d2 = 0.f;
    for (int i = 0; i < 64; ++i) { d1 += P.in[8][i] * P.in[9][i]; d2 += P.in[10][i] * P.in[11][i]; }
    const float lam = expf(d1) - expf(d2) + 0.2f;
    const int tid = opaque_tid(), lane = tid & 63, wid = __builtin_amdgcn_readfirstlane(tid >> 6);
    const int comp = wid & 1, rg = wid >> 1, r = lane & 31, h2 = lane >> 5;
    const int pr = (r & 19) | ((r & 4) << 1) | ((r & 8) >> 1);
    const int kro = pr * 128, kyb = 16 * (h2 ^ ((pr >> 1) & 7)), vro = r * 128, vyb = 16 * (h2 ^ ((r >> 1) & 7));
    int ntiles = 0; for (int u = blockIdx.x; u < 2048; u += G) ntiles += 2;
#define ATT_BARV(N) do { asm volatile("s_waitcnt vmcnt(" #N ") lgkmcnt(0)" ::: "memory"); __builtin_amdgcn_s_barrier(); asm volatile("" ::: "memory"); } while (0)
#define ATT_BARL() do { asm volatile("s_waitcnt lgkmcnt(0)" ::: "memory"); __builtin_amdgcn_s_barrier(); asm volatile("" ::: "memory"); } while (0)
#define ATT_SETUP(B_, H_, QT_, KGP, VGP, QF) do { \
    _Pragma("unroll") for (int i = 0; i < 2; ++i) { \
        const int j = wid * 2 + i; \
        const int krow = (j & 7) * 8 + (lane >> 3), kc = (lane & 7) ^ ((krow >> 1) & 7); \
        KGP[i] = Kg + ((size_t)((B_) * 8 + (H_)) * SEQ + krow) * 128 + (j >> 3) * 64 + kc * 8; \
        const int d = j * 8 + (lane >> 3), vc = (lane & 7) ^ ((d >> 1) & 7); \
        VGP[i] = Vtg + (size_t)((B_) * 8 + (H_)) * 128 * 8192 + d * 64 + vc * 8; } \
    const bf16_t* qp = Qg + ((size_t)(B_) * SEQ + (QT_) * 128 + rg * 32 + r) * DM + (H_) * 128 + comp * 64 + 8 * h2; \
    _Pragma("unroll") for (int kk = 0; kk < 4; ++kk) QF[kk] = *(const bf16x8*)(qp + 16 * kk); } while (0)
    if (ntiles == 0) return;
    int b, h, qt; att_tile_id(0, G, b, h, qt);
    const bf16_t* kgp[2]; const bf16_t* vgp[2]; bf16x8 qf[4];
    ATT_SETUP(b, h, qt, kgp, vgp, qf);
    ATT_DMA_K(0, 0); ATT_DMA_K(1, 1); if (qt > 0) ATT_DMA_K(2, 2);
    for (int idx = 0; idx < ntiles; ++idx) {
        const int q0 = qt * 128 + rg * 32;
        const int nkt = 2 * qt + 2, nkt_w = 2 * qt + (rg >> 1) + 1;
        const size_t tokbase = (size_t)b * SEQ;
        ATT_DMA_V(0, 0); ATT_DMA_V(1, 1);
        ATT_BARV(2);
        f32x16 o[4];
#pragma unroll
        for (int d = 0; d < 4; ++d)
#pragma unroll
            for (int i = 0; i < 16; ++i) o[d][i] = 0.f;
        float lrun = 0.f;
        f32x16 sA, sB, negm; float cmx;
        {
            LAS const unsigned char* Kb0 = lds + comp * ATT_KCOMP;
            f32x16 z;
#pragma unroll
            for (int i = 0; i < 16; ++i) z[i] = 0.f;
            sA = z;
#pragma unroll
            for (int kk = 0; kk < 4; ++kk) sA = __builtin_amdgcn_mfma_f32_32x32x16_bf16(att_kfrag(Kb0, kro, kk, kyb), qf[kk], sA, 0, 0, 0);
            const float m0 = att_rowmax1(sA);
#pragma unroll
            for (int i = 0; i < 16; ++i) { sA[i] -= m0; negm[i] = -m0; }
            cmx = 0.f;
            sB = z;
        }
        int vb_cur = 0, vb_fill = 2;
        for (int kt = 0; kt < nkt - 1; ++kt) {
            const bool dk = (kt + 3 < nkt), dv = (kt + 2 < nkt);
            if (dk) ATT_DMA_K(kt + 3, (kt + 3) & 3);
            LAS const unsigned char* Vb = lds + ATT_VBASE + vb_cur * ATT_VBUF;
            att_half<true>(sA, sB, o, qf, negm, lrun, cmx, lds + (kt & 3) * ATT_KBUF + comp * ATT_KCOMP + 4096, Vb, 0, kro, kyb, vro, vyb);
            if (dv) ATT_DMA_V(kt + 2, vb_fill);
            att_half<true>(sB, sA, o, qf, negm, lrun, cmx, lds + ((kt + 1) & 3) * ATT_KBUF + comp * ATT_KCOMP, Vb, 2, kro, kyb, vro, vyb);
            vb_cur = (vb_cur == 2) ? 0 : vb_cur + 1; vb_fill = (vb_fill == 2) ? 0 : vb_fill + 1;
            if (dk) ATT_BARV(4); else if (dv) ATT_BARV(2); else ATT_BARV(0);
        }
        if (nkt_w == nkt) {
            LAS const unsigned char* Vb = lds + ATT_VBASE + vb_cur * ATT_VBUF;
            att_half<true>(sA, sB, o, qf, negm, lrun, cmx, lds + ((nkt - 1) & 3) * ATT_KBUF + comp * ATT_KCOMP + 4096, Vb, 0, kro, kyb, vro, vyb);
            att_half<false>(sB, sA, o, qf, negm, lrun, cmx, lds + (nkt & 3) * ATT_KBUF + comp * ATT_KCOMP, Vb, 2, kro, kyb, vro, vyb);
        }
        ATT_BARV(0);
        int nb = b, nh = h, nqt = qt; const bool has_next = idx + 1 < ntiles;
        const bf16_t* kgn[2] = {kgp[0], kgp[1]}; const bf16_t* vgn[2] = {vgp[0], vgp[1]}; bf16x8 qn[4] = {qf[0], qf[1], qf[2], qf[3]};
        if (has_next) {
            att_tile_id(idx + 1, G, nb, nh, nqt);
            ATT_SETUP(nb, nh, nqt, kgn, vgn, qn);
            { const bf16_t* const* kgp_s = kgn; (void)kgp_s; }
#define kgp kgn
            ATT_DMA_K(0, 0); ATT_DMA_K(1, 1); if (nqt > 0) ATT_DMA_K(2, 2);
#undef kgp
        }
        const float ltot = lrun + __shfl_xor(lrun, 32);
        const float inv = 1.0f / ltot;
        LAS float* xs = (LAS float*)(lds + 65536) + rg * 4096;
        if (comp == 1) {
#pragma unroll
            for (int d = 0; d < 4; ++d)
#pragma unroll
                for (int i = 0; i < 16; ++i) xs[(d * 16 + i) * 64 + lane] = o[d][i] * inv;
        }
        ATT_BARL();
        if (comp == 0) {
            float ssq = 0.f;
#pragma unroll
            for (int d = 0; d < 4; ++d)
#pragma unroll
                for (int i = 0; i < 16; ++i) { const float v = o[d][i] * inv - lam * xs[(d * 16 + i) * 64 + lane]; o[d][i] = v; ssq += v * v; }
            ssq += __shfl_xor(ssq, 32);
            const float rs = rsqrtf(ssq * (1.0f / 128.0f) + EPSV) * 0.8f;
            bf16_t* op = Og + (tokbase + q0 + r) * DM + h * 128;
#pragma unroll
            for (int d = 0; d < 4; ++d)
#pragma unroll
                for (int k2 = 0; k2 < 2; ++k2) {
                    u32x2 wa, wb;
                    { const int g4 = 2 * k2, dd = 32 * d + 8 * g4 + 4 * h2; const f32x4 gg = *(const f32x4*)(subg + dd);
                      wa.x = cvt_pk_bf16(o[d][4 * g4 + 0] * rs * gg[0], o[d][4 * g4 + 1] * rs * gg[1]); wa.y = cvt_pk_bf16(o[d][4 * g4 + 2] * rs * gg[2], o[d][4 * g4 + 3] * rs * gg[3]); }
                    { const int g4 = 2 * k2 + 1, dd = 32 * d + 8 * g4 + 4 * h2; const f32x4 gg = *(const f32x4*)(subg + dd);
                      wb.x = cvt_pk_bf16(o[d][4 * g4 + 0] * rs * gg[0], o[d][4 * g4 + 1] * rs * gg[1]); wb.y = cvt_pk_bf16(o[d][4 * g4 + 2] * rs * gg[2], o[d][4 * g4 + 3] * rs * gg[3]); }
                    const auto sx = __builtin_amdgcn_permlane32_swap(wa.x, wb.x, false, false);
                    const auto sy = __builtin_amdgcn_permlane32_swap(wa.y, wb.y, false, false);
                    u32x4 w; w.x = sx[0]; w.y = sy[0]; w.z = sx[1]; w.w = sy[1];
                    *(u32x4*)(op + 32 * d + 16 * k2 + 8 * h2) = w;
                }
        }
        ATT_BARL();
        b = nb; h = nh; qt = nqt;
#pragma unroll
        for (int i = 0; i < 2; ++i) { kgp[i] = kgn[i]; vgp[i] = vgn[i]; }
#pragma unroll
        for (int kk = 0; kk < 4; ++kk) qf[kk] = qn[kk];
    }
    asm volatile("s_waitcnt vmcnt(0)" ::: "memory");
#undef ATT_BARV
#undef ATT_BARL
#undef ATT_SETUP
}

#define XB_TMO      128
#define XB_XCNT(j)  (256  + 64 * (j))
#define XB_XSUB(j)  (1280 + 64 * (j))
#define XB_XGEN(j)  (2304 + 64 * (j))
#define XB_TOP      3328
#define XB_TOPGEN   3392
#define XCD_BAR_WORDS 3456
#define XB_SPIN_CAP (1u << 22)
DI unsigned xb_ld(unsigned* p)              { return __hip_atomic_load(p, __ATOMIC_RELAXED, __HIP_MEMORY_SCOPE_AGENT); }
DI unsigned xb_add(unsigned* p, unsigned v) { return __hip_atomic_fetch_add(p, v, __ATOMIC_RELAXED, __HIP_MEMORY_SCOPE_AGENT); }
DI unsigned xb_xcc_id() { return (unsigned)__builtin_amdgcn_s_getreg((3 << 11) | 20) & 0xFu; }
#define XB_SPIN(cond, bar) do { unsigned _sp = 0; while (cond) { __builtin_amdgcn_s_sleep(1); \
    if ((++_sp & 255u) == 0u) { if (xb_ld(&(bar)[XB_TMO])) break; if (_sp > XB_SPIN_CAP) { atomicAdd(&(bar)[XB_TMO], 1u); break; } } } } while (0)
struct XcdBarrier { unsigned* bar; unsigned x; volatile LAS unsigned* st; };
DI XcdBarrier xcd_barrier_post(unsigned* bar, volatile LAS unsigned* st) {
    XcdBarrier b; b.bar = bar; b.x = xb_xcc_id(); b.st = st;
    if (threadIdx.x == 0) (void)xb_add(&bar[XB_XCNT(b.x)], 1u);
    return b;
}
DI void xcd_barrier_complete(unsigned* bar, unsigned x, unsigned& nloc, unsigned& nx) {
    const unsigned G = gridDim.x * gridDim.y * gridDim.z;
    unsigned sum, cnt, mine, sp = 0u;
    for (;;) {
        sum = 0u; cnt = 0u; mine = 0u;
#pragma unroll
        for (unsigned j = 0; j < 16; ++j) { const unsigned c = xb_ld(&bar[XB_XCNT(j)]); sum += c; cnt += (c > 0u) ? 1u : 0u; mine = (j == x) ? c : mine; }
        if (sum == G) break;
        __builtin_amdgcn_s_sleep(1);
        if ((++sp & 255u) == 0u) { if (xb_ld(&bar[XB_TMO])) break; if (sp > XB_SPIN_CAP) { atomicAdd(&bar[XB_TMO], 1u); break; } }
    }
    nloc = mine > 0u ? mine : 1u; nx = cnt > 0u ? cnt : 1u;
}
DI void xcd_barrier(const XcdBarrier& b) {
    asm volatile("s_waitcnt vmcnt(0)" ::: "memory");
    __syncthreads();
    if (threadIdx.x == 0) {
        unsigned* bar = b.bar;
        __builtin_amdgcn_s_waitcnt(0);
        unsigned nloc = b.st[0], nx = b.st[1];
        if (nloc == 0u) { xcd_barrier_complete(bar, b.x, nloc, nx); b.st[0] = nloc; b.st[1] = nx; }
        const unsigned old = xb_add(&bar[XB_XSUB(b.x)], 1u);
        const unsigned gen = old / nloc;
        if (old + 1u == (gen + 1u) * nloc) {
            __builtin_amdgcn_fence(__ATOMIC_RELEASE, "agent");
            asm volatile("s_waitcnt vmcnt(0)" ::: "memory");
            const unsigned og = xb_add(&bar[XB_TOP], 1u);
            const unsigned tg = og / nx;
            if (og + 1u == (tg + 1u) * nx) xb_add(&bar[XB_TOPGEN], 1u);
            else XB_SPIN(xb_ld(&bar[XB_TOPGEN]) == tg, bar);
            __builtin_amdgcn_fence(__ATOMIC_ACQUIRE, "agent");
            xb_add(&bar[XB_XGEN(b.x)], 1u);
            asm volatile("s_waitcnt vmcnt(0)" ::: "memory");
        } else {
            XB_SPIN(xb_ld(&bar[XB_XGEN(b.x)]) == gen, bar);
            __builtin_amdgcn_fence(__ATOMIC_ACQUIRE, "agent");
            asm volatile("s_waitcnt vmcnt(0)" ::: "memory");
        }
    }
    __syncthreads();
}

DI GemmJob make_job(const Params& P, int ph, int g) {
    unsigned char* ws = P.ws; unsigned char* misc = ws + 7 * SLOT;
    GemmJob J{};
    J.ldc = DM; J.rope = (const float*)(misc + OFF_ROPE);
    if (ph == 1 && g == 0) { J.A = (const bf16_t*)ws; J.Bt = (const bf16_t*)(misc + OFF_WIN); J.M = MT; J.N = 6144; J.K = DM; J.mode = EPI_IN; J.in_base = (bf16_t*)(ws + SLOT); J.gb_base = (bf16_t*)P.out; }
    else if (ph == 1) { J.A = (const bf16_t*)(misc + OFF_WVA); J.Bt = (const bf16_t*)ws; J.M = 1024; J.N = MT; J.K = DM; J.mode = EPI_VT; J.o0 = (bf16_t*)(ws + 5 * SLOT); J.ldc = MT; }
    else if (ph == 3 && g == 0) { J.A = (const bf16_t*)(ws + SLOT); J.Bt = (const bf16_t*)(misc + OFF_WA); J.M = MT; J.N = DM; J.K = DM; J.mode = EPI_BRA; J.o0 = (bf16_t*)(ws + 6 * SLOT); }
    else if (ph == 3) { J.A = (const bf16_t*)(ws + 3 * SLOT); J.Bt = (const bf16_t*)(misc + OFF_WB); J.M = MT; J.N = DM; J.K = DM; J.mode = EPI_BRB; J.o0 = (bf16_t*)P.out; J.i0 = (const bf16_t*)(ws + 6 * SLOT); }
    else if (ph == 4) { J.A = (const bf16_t*)P.out; J.Bt = (const bf16_t*)(misc + OFF_WO); J.M = MT; J.N = DM; J.K = DM; J.mode = EPI_RAW; J.fo = (float*)(ws + 2 * SLOT); J.ss = (float*)(misc + OFF_SS); }
    else if (ph == 6) { J.A = (const bf16_t*)P.out; J.Bt = (const bf16_t*)(misc + OFF_WF1); J.M = MT; J.N = FFW; J.K = DM; J.mode = EPI_RELU2; J.o0 = (bf16_t*)(ws + 3 * SLOT); J.ldc = FFW; }
    else if (ph == 7) { J.A = (const bf16_t*)(ws + 3 * SLOT); J.Bt = (const bf16_t*)(misc + OFF_WF2); J.M = MT; J.N = DM; J.K = FFW; J.mode = EPI_RAW; J.fo = P.out; J.ss = (float*)(misc + OFF_SS) + MT; }
    else if (ph == 9 && g == 0) { J.A = (const bf16_t*)(misc + OFF_PB); J.Bt = (const bf16_t*)(misc + OFF_WP); J.M = MT; J.N = DM; J.K = PLED; J.mode = EPI_BF16; J.o0 = (bf16_t*)(ws + 3 * SLOT); }
    else { J.A = (const bf16_t*)(ws + 2 * SLOT); J.Bt = (const bf16_t*)(misc + OFF_WG); J.M = MT; J.N = DM; J.K = DM; J.mode = EPI_GATE; J.fo = (float*)(ws + 4 * SLOT); J.ss = (float*)(misc + OFF_SS) + 2 * MT;
           J.i0 = (const bf16_t*)(ws + 3 * SLOT); J.bias = P.in[23]; }
    return J;
}

__global__ void __launch_bounds__(512, 2) mega_fwd(Params P) {
    extern __shared__ __attribute__((aligned(16))) unsigned char lds_raw[];
    LAS unsigned char* lds = (LAS unsigned char*)lds_raw;
    cg::grid_group grid = cg::this_grid();
    const int G = gridDim.x;
    volatile LAS unsigned* stw = (volatile LAS unsigned*)(lds + 131072);
    if (threadIdx.x < 4) stw[threadIdx.x] = 0u;
    __syncthreads();
    const XcdBarrier xb = xcd_barrier_post((unsigned*)(P.ws + 7 * SLOT + OFF_BAR), stw);
    for (int ph = P.ph_lo; ph < P.ph_hi; ++ph) {
        if (ph > P.ph_lo) {
            if (P.ph_lo != 0) grid.sync();
            else xcd_barrier(xb);
        }
        int ngemm = 0;
        if (ph == 0) { if (PHMASK & 1) prologue(lds, P, G); }
        else if (ph == 2) { if (PHMASK & 2) gmlp_phase(lds, P, G); if (PHMASK & 4) attn_phase(lds, P, G); }
        else if (ph == 5) { if (PHMASK & 8) elementwise_phase(P, 0, G); }
        else if (ph == 8) { if (PHMASK & 8) elementwise_phase(P, 1, G); }
        else if (ph == 10) { if (PHMASK & 8) elementwise_phase(P, 2, G); }
        else ngemm = (ph == 1 || ph == 3 || ph == 9) ? 2 : 1;
        if (PHMASK & 16) for (int g = 0; g < ngemm; ++g) {
            const GemmJob J = make_job(P, ph, g);
            gemm_phase(lds, J, G, blockIdx.x);
        }
    }
}

extern "C" void kernel_launch(void* const* d_in, const int* in_sizes, int n_in, void* d_out, int out_size, void* d_ws, size_t ws_size, hipStream_t stream) {
    static int grid_blocks = 0;
    if (!grid_blocks) {
        int dev = 0, cus = 0, per_cu = 0;
        hipGetDevice(&dev);
        hipDeviceGetAttribute(&cus, hipDeviceAttributeMultiprocessorCount, dev);
        if (hipFuncSetAttribute((const void*)mega_fwd, hipFuncAttributeMaxDynamicSharedMemorySize, LDS_BYTES) != hipSuccess) fprintf(stderr, "hipFuncSetAttribute failed\n");
        hipOccupancyMaxActiveBlocksPerMultiprocessor(&per_cu, (const void*)mega_fwd, 512, LDS_BYTES);
        if (per_cu < 1) { fprintf(stderr, "occupancy query returned %d\n", per_cu); per_cu = 1; }
        grid_blocks = cus * per_cu;
        if (ws_size < 8 * SLOT) fprintf(stderr, "workspace too small: %zu\n", ws_size);
    }
    Params p{};
    for (int i = 0; i < 25; ++i) p.in[i] = (const float*)d_in[i];
    p.out = (float*)d_out; p.ws = (unsigned char*)d_ws; p.ph_lo = 0; p.ph_hi = NPHASE;
    if (hipMemsetAsync((char*)d_ws + 7 * SLOT + OFF_BAR, 0, 16384, stream) != hipSuccess) fprintf(stderr, "hipMemsetAsync of the barrier words failed\n");
    void* args[] = {&p};
    hipError_t e = hipLaunchCooperativeKernel((const void*)mega_fwd, dim3(grid_blocks), dim3(512), args, LDS_BYTES, stream);
    if (e != hipSuccess) fprintf(stderr, "cooperative launch failed: %s (grid %d)\n", hipGetErrorString(e), grid_blocks);
}
```

```cpp
#include <hip/hip_runtime.h>
#include <hip/hip_cooperative_groups.h>
#include <cstdio>
namespace cg = cooperative_groups;

#define LAS __attribute__((address_space(3)))
#define DI __device__ __forceinline__
typedef unsigned short bf16_t;
typedef short bf16x8 __attribute__((ext_vector_type(8)));
typedef float f32x4 __attribute__((ext_vector_type(4)));
typedef float f32x16 __attribute__((ext_vector_type(16)));
typedef unsigned u32x4 __attribute__((ext_vector_type(4)));
typedef unsigned u32x2 __attribute__((ext_vector_type(2)));

constexpr int MT = 65536, DM = 1024, SEQ = 8192, FFW = 4096, PLED = 256;
constexpr float EPSV = 1e-6f;
constexpr size_t SLOT = (size_t)1 << 27;
constexpr size_t OFF_WIN = 0;
constexpr size_t OFF_WVA = OFF_WIN + (size_t)6144 * 1024 * 2;
constexpr size_t OFF_WA = OFF_WVA + (size_t)1024 * 1024 * 2;
constexpr size_t OFF_WB = OFF_WA + (size_t)1024 * 1024 * 2;
constexpr size_t OFF_WO = OFF_WB + (size_t)1024 * 1024 * 2;
constexpr size_t OFF_WF1 = OFF_WO + (size_t)1024 * 1024 * 2;
constexpr size_t OFF_WF2 = OFF_WF1 + (size_t)4096 * 1024 * 2;
constexpr size_t OFF_WP = OFF_WF2 + (size_t)4096 * 1024 * 2;
constexpr size_t OFF_WG = OFF_WP + (size_t)1024 * 256 * 2;
constexpr size_t OFF_ROPE = OFF_WG + (size_t)1024 * 1024 * 2;
constexpr size_t OFF_SS = OFF_ROPE + (size_t)8192 * 32 * 8;
constexpr size_t OFF_WS = OFF_SS + (size_t)3 * 65536 * 4;
constexpr size_t OFF_PB = OFF_WS + (size_t)8 * 128 * 128 * 2;
constexpr size_t OFF_END = OFF_PB + (size_t)65536 * 256 * 2;
constexpr size_t OFF_BAR = OFF_END;
static_assert(OFF_BAR + 16384 <= SLOT, "misc region overflow");

constexpr int LDS_BYTES = 131072 + 16;
constexpr int NPHASE = 11;
#ifndef STAGGER_TICKS
#define STAGGER_TICKS 700
#endif
#ifndef PHMASK
#define PHMASK 31
#endif

struct Params {
    const float* in[25];
    float* out;
    unsigned char* ws;
    int ph_lo, ph_hi;
};

typedef __bf16 bf16x2n __attribute__((ext_vector_type(2)));
typedef float f32x2n __attribute__((ext_vector_type(2)));
DI unsigned cvt_pk_bf16(float lo, float hi) { const f32x2n v = {lo, hi}; return __builtin_bit_cast(unsigned, __builtin_convertvector(v, bf16x2n)); }
DI float bf_lo(unsigned w) { return __uint_as_float(w << 16); }
DI float bf_hi(unsigned w) { return __uint_as_float(w & 0xffff0000u); }
DI float fast_exp2(float x) { return __builtin_amdgcn_exp2f(x); }
DI float fast_rcp(float x) { return __builtin_amdgcn_rcpf(x); }
DI float sigmoid_f(float x) { return fast_rcp(1.0f + fast_exp2(-1.4426950408889634f * x)); }
DI float gelu_tanh(float x) { const float u = x * (0.7978845608028654f + 0.035677408136300125f * x * x); return x * fast_rcp(1.0f + fast_exp2(-2.885390081777927f * u)); }
DI int opaque_tid() { int t = threadIdx.x; asm volatile("" : "+v"(t)); return t; }
DI float xhalf_max(float x) { const auto r = __builtin_amdgcn_permlane32_swap(__float_as_uint(x), __float_as_uint(x), false, false); return fmaxf(__uint_as_float(r[0]), __uint_as_float(r[1])); }
DI float wave_sum(float v) { v += __shfl_xor(v, 32); v += __shfl_xor(v, 16); v += __shfl_xor(v, 8); v += __shfl_xor(v, 4); v += __shfl_xor(v, 2); v += __shfl_xor(v, 1); return v; }

constexpr int BM = 256, BK = 64, HALF = 128, HTB = HALF * BK * 2, NXCD = 8, WGM = 8;
DI int lds_byte(int r, int c) { const int st = (r >> 4) * 2 + (c >> 5), rr = r & 15, cc = c & 31, ob = rr * 64 + cc * 2; return st * 1024 + (ob ^ (((ob >> 9) & 1) << 5)); }
DI void stage_rc(int b, int& R, int& C) { const int st = b / 1024, sb = b % 1024, swz = sb ^ (((sb >> 9) & 1) << 5); R = (st >> 1) * 16 + swz / 64; C = (st & 1) * 32 + (swz % 64) / 2; }
DI int perm32(int rho) { const int n = rho >> 4, i = rho & 15; return 8 * (i >> 2) + 4 * n + (i & 3); }
struct Unit { int pm, pn; };
struct StaticOrder {
    int nM, nN, nwg, G, c;
    DI void init(int M, int N, int G_, int c_) { nM = M / BM; nN = N / BM; nwg = nM * nN; G = G_; c = c_; }
    DI bool next(int i, Unit& u) const {
        const long L = (long)i * G + c; if (L >= nwg) return false;
        int wgid = (int)L; { const int q = nwg / NXCD, r = nwg % NXCD, xcd = wgid % NXCD, off = wgid / NXCD; wgid = (xcd < r ? xcd * (q + 1) : r * (q + 1) + (xcd - r) * q) + off; }
        const int nig = WGM * nN, gid = wgid / nig, fm = gid * WGM, gsz = (nM - fm) < WGM ? (nM - fm) : WGM;
        u.pm = fm + ((wgid % nig) % gsz); u.pn = (wgid % nig) / gsz; return true;
    }
};

enum { EPI_IN = 0, EPI_BF16 = 1, EPI_BRA = 2, EPI_BRB = 3, EPI_RAW = 4, EPI_RELU2 = 5, EPI_GATE = 6, EPI_VT = 7 };
struct GemmJob {
    const bf16_t* A; const bf16_t* Bt; int M, N, K; int mode;
    bf16_t* o0; int ldc;
    const bf16_t* i0;
    float* fo; float* ss; const float* bias;
    bf16_t* in_base;
    bf16_t* gb_base;
    const float* rope;
};

constexpr float QSCALE = 0.125f * 1.4426950408889634f;

DI void epilogue(const f32x4 (&acc)[2][2][4][2], const Unit& u, int wr, int wc, int fr, int fq, const GemmJob& J) {
    const int mode = J.mode;
    if (mode == EPI_IN) {
        const int region = u.pn >> 2;
        bf16_t* base = region == 0 ? J.in_base : region == 1 ? J.in_base + (SLOT / 2) : region == 2 ? J.in_base + 2 * (SLOT / 2) : region == 3 ? J.in_base + 3 * (SLOT / 2)
                     : region == 4 ? J.in_base + 5 * (SLOT / 2) : J.gb_base;
        const int row0 = u.pm * BM + wr * 64 + fr, col0 = (u.pn & 3) * BM + wc * 32 + 8 * fq;
#pragma unroll
        for (int ai = 0; ai < 2; ++ai)
#pragma unroll
            for (int m = 0; m < 4; ++m) {
                const int row = row0 + ai * HALF + m * 16;
                bf16_t* rowp = base + (size_t)row * DM + col0;
                f32x4 t0 = {1.f, 0.f, 1.f, 0.f}, t1 = {1.f, 0.f, 1.f, 0.f};
                if (region == 2 || region == 3) {
                    const float* tp = J.rope + ((size_t)(row & (SEQ - 1)) * 32 + 16 * (wc & 1) + 4 * fq) * 2;
                    t0 = *(const f32x4*)tp; t1 = *(const f32x4*)(tp + 4);
                }
#pragma unroll
                for (int bj = 0; bj < 2; ++bj) {
                    f32x4 v0 = acc[ai][bj][m][0], v1 = acc[ai][bj][m][1];
                    if (region < 2) {
#pragma unroll
                        for (int j = 0; j < 4; ++j) { v0[j] = gelu_tanh(v0[j]); v1[j] = gelu_tanh(v1[j]); }
                    } else if (region < 4) {
                        const float sc = region == 2 ? QSCALE : 1.0f;
                        f32x4 a, b;
                        a[0] = (v0[0] * t0[0] - v0[1] * t0[1]) * sc; a[1] = (v0[1] * t0[0] + v0[0] * t0[1]) * sc;
                        a[2] = (v0[2] * t0[2] - v0[3] * t0[3]) * sc; a[3] = (v0[3] * t0[2] + v0[2] * t0[3]) * sc;
                        b[0] = (v1[0] * t1[0] - v1[1] * t1[1]) * sc; b[1] = (v1[1] * t1[0] + v1[0] * t1[1]) * sc;
                        b[2] = (v1[2] * t1[2] - v1[3] * t1[3]) * sc; b[3] = (v1[3] * t1[2] + v1[2] * t1[3]) * sc;
                        v0 = a; v1 = b;
                    } else {
#pragma unroll
                        for (int j = 0; j < 4; ++j) { v0[j] = sigmoid_f(v0[j]); v1[j] = sigmoid_f(v1[j]); }
                    }
                    u32x4 w; w.x = cvt_pk_bf16(v0[0], v0[1]); w.y = cvt_pk_bf16(v0[2], v0[3]); w.z = cvt_pk_bf16(v1[0], v1[1]); w.w = cvt_pk_bf16(v1[2], v1[3]);
                    if (region == 3) {
                        const size_t ko = ((size_t)((row >> 13) * 8 + (u.pn & 3) * 2 + bj) * SEQ + (row & (SEQ - 1))) * 128 + wc * 32 + 8 * fq;
                        *(u32x4*)(base + ko) = w;
                    } else *(u32x4*)(rowp + bj * HALF) = w;
                }
            }
    } else if (mode == EPI_BF16 || mode == EPI_RELU2 || mode == EPI_BRA || mode == EPI_BRB || mode == EPI_VT) {
        const bool widem = (mode == EPI_BRA || mode == EPI_BRB);
        const int wcs = widem ? 64 : 32, bjs = widem ? 32 : HALF;
        const int row0 = u.pm * BM + wr * 64 + fr, col0 = u.pn * BM + wc * wcs + 8 * fq;
#pragma unroll
        for (int ai = 0; ai < 2; ++ai)
#pragma unroll
            for (int m = 0; m < 4; ++m) {
                const size_t off = (size_t)(row0 + ai * HALF + m * 16) * J.ldc + col0;
#pragma unroll
                for (int bj = 0; bj < 2; ++bj) {
                    f32x4 v0 = acc[ai][bj][m][0], v1 = acc[ai][bj][m][1];
                    if (mode == EPI_RELU2) {
#pragma unroll
                        for (int j = 0; j < 4; ++j) { const float a = fmaxf(v0[j], 0.f), b = fmaxf(v1[j], 0.f); v0[j] = a * a; v1[j] = b * b; }
                    } else if (mode == EPI_BRA || mode == EPI_BRB) {
                        const u32x4 g = *(const u32x4*)(J.o0 + off + bj * bjs);
                        v0[0] *= bf_lo(g.x); v0[1] *= bf_hi(g.x); v0[2] *= bf_lo(g.y); v0[3] *= bf_hi(g.y);
                        v1[0] *= bf_lo(g.z); v1[1] *= bf_hi(g.z); v1[2] *= bf_lo(g.w); v1[3] *= bf_hi(g.w);
                        if (mode == EPI_BRB) {
                            const u32x4 t = *(const u32x4*)(J.i0 + off + bj * bjs);
                            v0[0] += bf_lo(t.x); v0[1] += bf_hi(t.x); v0[2] += bf_lo(t.y); v0[3] += bf_hi(t.y);
                            v1[0] += bf_lo(t.z); v1[1] += bf_hi(t.z); v1[2] += bf_lo(t.w); v1[3] += bf_hi(t.w);
                        }
                    }
                    u32x4 w; w.x = cvt_pk_bf16(v0[0], v0[1]); w.y = cvt_pk_bf16(v0[2], v0[3]); w.z = cvt_pk_bf16(v1[0], v1[1]); w.w = cvt_pk_bf16(v1[2], v1[3]);
                    if (mode == EPI_VT) {
                        const int feat = row0 + ai * HALF + m * 16, tok = col0 + bj * bjs;
                        const size_t vo = ((((size_t)((tok >> 13) * 8 + (feat >> 7)) * 128 + ((tok & (SEQ - 1)) >> 6)) * 128 + (feat & 127)) * 64) + (tok & 63);
                        *(u32x4*)(J.o0 + vo) = w;
                    } else
                    *(u32x4*)(J.o0 + off + bj * bjs) = w;
                }
            }
    } else {
        const int row0 = u.pm * BM + wr * 64 + fr, col0 = u.pn * BM + wc * 64 + 8 * fq;
#pragma unroll
        for (int ai = 0; ai < 2; ++ai)
#pragma unroll
            for (int m = 0; m < 4; ++m) {
                const int row = row0 + ai * HALF + m * 16;
                const size_t off = (size_t)row * DM + col0;
                float s = 0.f;
#pragma unroll
                for (int bj = 0; bj < 2; ++bj) {
                    f32x4 v0 = acc[ai][bj][m][0], v1 = acc[ai][bj][m][1];
                    if (mode == EPI_GATE) {
                        const f32x4 b0 = *(const f32x4*)(J.bias + col0 + bj * 32), b1 = *(const f32x4*)(J.bias + col0 + bj * 32 + 4);
                        const u32x4 e = *(const u32x4*)(J.i0 + off + bj * 32);
                        v0[0] = bf_lo(e.x) * sigmoid_f(v0[0] + b0[0]); v0[1] = bf_hi(e.x) * sigmoid_f(v0[1] + b0[1]);
                        v0[2] = bf_lo(e.y) * sigmoid_f(v0[2] + b0[2]); v0[3] = bf_hi(e.y) * sigmoid_f(v0[3] + b0[3]);
                        v1[0] = bf_lo(e.z) * sigmoid_f(v1[0] + b1[0]); v1[1] = bf_hi(e.z) * sigmoid_f(v1[1] + b1[1]);
                        v1[2] = bf_lo(e.w) * sigmoid_f(v1[2] + b1[2]); v1[3] = bf_hi(e.w) * sigmoid_f(v1[3] + b1[3]);
                    }
                    u32x4 w; w.x = cvt_pk_bf16(v0[0], v0[1]); w.y = cvt_pk_bf16(v0[2], v0[3]); w.z = cvt_pk_bf16(v1[0], v1[1]); w.w = cvt_pk_bf16(v1[2], v1[3]);
                    *(u32x4*)((bf16_t*)J.fo + off + bj * 32) = w;
                    s += ((v0[0] * v0[0] + v0[1] * v0[1]) + (v0[2] * v0[2] + v0[3] * v0[3])) + ((v1[0] * v1[0] + v1[1] * v1[1]) + (v1[2] * v1[2] + v1[3] * v1[3]));
                }
                s += __shfl_xor(s, 16); s += __shfl_xor(s, 32);
                if (fq == 0) atomicAdd(J.ss + row, s);
            }
    }
}

DI void gemm_phase(LAS unsigned char* lds, const GemmJob& J, int G, int cidx) {
    const int tid = opaque_tid(), wid = __builtin_amdgcn_readfirstlane(tid >> 6), lane = tid & 63, wr = wid >> 2, wc = wid & 3, fr = lane & 15, fq = lane >> 4;
    const int K = J.K, nt = K / BK;
    const bool perm = true;
    const bool wide = (J.mode == EPI_BRA || J.mode == EPI_BRB || J.mode == EPI_RAW || J.mode == EPI_GATE);
    StaticOrder S; S.init(J.M, J.N, G, cidx);
    unsigned voffA[2], voffB[2];
#pragma unroll
    for (int i = 0; i < 2; ++i) { int R, C; stage_rc(tid * 16 + i * 8192, R, C); const int Rb = perm ? ((R & ~31) + perm32(R & 31)) : R;
        const int Rw = 64 * (R >> 5) + perm32(R & 31);
        voffA[i] = (unsigned)(R * K + C) * 2u; voffB[i] = (unsigned)((wide ? Rw : Rb) * K + C) * 2u; }
    const size_t kstep = (size_t)(BK * 2);
    const size_t hstep = (size_t)HALF * K * 2;
    const size_t tstep = 2 * hstep;
    const size_t hstepB = wide ? (size_t)32 * K * 2 : hstep;
    const unsigned ldsw = (unsigned)wid * 1024u;
    const int aoff = lds_byte(wr * 64 + fr, fq * 8), boff = lds_byte(wc * 32 + fr, fq * 8);
#define PG8_SA(b, h) (((b) * 2 + (h)) * HTB)
#define PG8_SB(b, h) ((4 + (b) * 2 + (h)) * HTB)
#define PG8_STAGE(bufoff, gbase, voff) do { _Pragma("unroll") for (int _i = 0; _i < 2; ++_i) \
        __builtin_amdgcn_global_load_lds((const unsigned*)((const char*)(gbase) + (voff)[_i]), (LAS unsigned*)(lds + (bufoff) + ldsw + _i * 8192), 16, 0, 0); } while (0)
#define PG8_LDA(dst, b, h) do { _Pragma("unroll") for (int m = 0; m < 4; ++m) _Pragma("unroll") for (int k = 0; k < 2; ++k) dst[m][k] = *(const LAS bf16x8*)(lds + PG8_SA(b, h) + aoff + m * 2048 + k * 1024); } while (0)
#define PG8_LDB(dst, b, h) do { _Pragma("unroll") for (int n = 0; n < 2; ++n) _Pragma("unroll") for (int k = 0; k < 2; ++k) dst[n][k] = *(const LAS bf16x8*)(lds + PG8_SB(b, h) + boff + n * 2048 + k * 1024); } while (0)
#define PG8_MMA(ai, bj, At, Bt) do { __builtin_amdgcn_s_setprio(1); _Pragma("unroll") for (int m = 0; m < 4; ++m) _Pragma("unroll") for (int n = 0; n < 2; ++n) _Pragma("unroll") for (int k = 0; k < 2; ++k) \
        acc[ai][bj][m][n] = __builtin_amdgcn_mfma_f32_16x16x32_bf16(Bt[n][k], At[m][k], acc[ai][bj][m][n], 0, 0, 0); __builtin_amdgcn_s_setprio(0); } while (0)
#define PG8_WAIT_V(n) asm volatile("s_waitcnt vmcnt(" #n ")" ::: "memory")
#define PG8_WAIT_L(n) asm volatile("s_waitcnt lgkmcnt(" #n ")" ::: "memory")
#define PG8_BAR __builtin_amdgcn_s_barrier()
#define PG8_SCHED __builtin_amdgcn_sched_barrier(0)
    Unit cur, nxt; int ui = 0;
    if (!S.next(0, cur)) return;
    f32x4 acc[2][2][4][2];
#pragma unroll
    for (int a = 0; a < 2; ++a)
#pragma unroll
        for (int b = 0; b < 2; ++b)
#pragma unroll
            for (int m = 0; m < 4; ++m)
#pragma unroll
                for (int n = 0; n < 2; ++n) acc[a][b][m][n] = (f32x4){0.f, 0.f, 0.f, 0.f};
    bf16x8 At[4][2], B0[2][2], B1[2][2];
    const char* cA = (const char*)J.A + (size_t)cur.pm * tstep; const char* cB = (const char*)J.Bt + (size_t)cur.pn * tstep;
    PG8_STAGE(PG8_SB(0, 0), cB, voffB); PG8_STAGE(PG8_SA(0, 0), cA, voffA); PG8_STAGE(PG8_SB(0, 1), cB + hstepB, voffB); PG8_STAGE(PG8_SA(0, 1), cA + hstep, voffA);
    if (wr == 1) PG8_BAR;
    PG8_WAIT_V(4); PG8_BAR;
    PG8_STAGE(PG8_SB(1, 0), cB + kstep, voffB); PG8_STAGE(PG8_SA(1, 0), cA + kstep, voffA); PG8_STAGE(PG8_SB(1, 1), cB + hstepB + kstep, voffB);
    PG8_WAIT_V(6); PG8_BAR;
    for (;;) {
        const bool has_next = S.next(ui + 1, nxt);
        const char* nA = has_next ? (const char*)J.A + (size_t)nxt.pm * tstep : cA; const char* nB = has_next ? (const char*)J.Bt + (size_t)nxt.pn * tstep : cB;
        for (int t = 0; t < nt; t += 2) {
            const bool last = (t == nt - 2);
            const char* a1 = cA + (size_t)(t + 1) * kstep;
            const char* a2 = last ? nA : cA + (size_t)(t + 2) * kstep; const char* b2 = last ? nB : cB + (size_t)(t + 2) * kstep;
            const char* a3 = a2 + kstep; const char* b3 = b2 + kstep;
            PG8_LDB(B0, 0, 0); PG8_SCHED; PG8_LDA(At, 0, 0); PG8_STAGE(PG8_SA(1, 1), a1 + hstep, voffA);
            PG8_WAIT_L(8); PG8_BAR; PG8_WAIT_L(0); PG8_MMA(0, 0, At, B0); PG8_BAR; PG8_SCHED;
            PG8_LDB(B1, 0, 1); PG8_STAGE(PG8_SB(0, 0), b2, voffB);
            PG8_BAR; PG8_WAIT_L(0); PG8_MMA(0, 1, At, B1); PG8_BAR;
            PG8_LDA(At, 0, 1); PG8_STAGE(PG8_SA(0, 0), a2, voffA);
            PG8_BAR; PG8_WAIT_L(0); PG8_MMA(1, 0, At, B0); PG8_BAR; PG8_SCHED;
            PG8_STAGE(PG8_SB(0, 1), b2 + hstepB, voffB);
            PG8_WAIT_V(6); PG8_BAR; PG8_MMA(1, 1, At, B1); PG8_BAR;
            PG8_LDB(B0, 1, 0); PG8_SCHED; PG8_LDA(At, 1, 0); PG8_STAGE(PG8_SA(0, 1), a2 + hstep, voffA);
            PG8_WAIT_L(8); PG8_BAR; PG8_WAIT_L(0); PG8_MMA(0, 0, At, B0); PG8_BAR; PG8_SCHED;
            PG8_LDB(B1, 1, 1); PG8_STAGE(PG8_SB(1, 0), b3, voffB);
            PG8_BAR; PG8_WAIT_L(0); PG8_MMA(0, 1, At, B1); PG8_BAR;
            PG8_LDA(At, 1, 1); PG8_STAGE(PG8_SA(1, 0), a3, voffA);
            PG8_BAR; PG8_WAIT_L(0); PG8_MMA(1, 0, At, B0); PG8_BAR; PG8_SCHED;
            PG8_STAGE(PG8_SB(1, 1), b3 + hstepB, voffB);
            PG8_WAIT_V(6); PG8_BAR; PG8_MMA(1, 1, At, B1); PG8_BAR;
        }
        epilogue(acc, cur, wr, wc, fr, fq, J);
        if (!has_next) break;
#pragma unroll
        for (int a = 0; a < 2; ++a)
#pragma unroll
            for (int b = 0; b < 2; ++b)
#pragma unroll
                for (int m = 0; m < 4; ++m)
#pragma unroll
                    for (int n = 0; n < 2; ++n) acc[a][b][m][n] = (f32x4){0.f, 0.f, 0.f, 0.f};
        cur = nxt; cA = nA; cB = nB; ++ui;
    }
    PG8_WAIT_V(0);
    if (wr == 0) PG8_BAR;
    PG8_BAR;
#undef PG8_SA
#undef PG8_SB
#undef PG8_STAGE
#undef PG8_LDA
#undef PG8_LDB
#undef PG8_MMA
#undef PG8_WAIT_V
#undef PG8_WAIT_L
#undef PG8_BAR
#undef PG8_SCHED
}

DI bf16_t* win_dstrow(int sc, bf16_t* win_t, bf16_t* wva_t) {
    if (sc < 2048) return win_t + (size_t)sc * DM;
    if (sc < 4096) { const int g = sc & ~63, d = sc & 63, p = ((d & 31) << 1) | (d >> 5); return win_t + (size_t)(g + p) * DM; }
    if (sc < 5120) return wva_t + (size_t)(sc - 4096) * DM;
    return win_t + (size_t)(sc - 1024) * DM;
}
struct TJob { const float* src; int Kdim, Ncols, tk, tn, mode; bf16_t* dst; bf16_t* dst2; };
DI TJob tjob(const Params& P, unsigned char* misc, int t) {
    TJob j; j.mode = 0; j.dst2 = nullptr;
    if (t < 1792) { j.src = P.in[3]; j.Kdim = 1024; j.Ncols = 7168; j.tk = t / 112; j.tn = t % 112; j.mode = 1; j.dst = (bf16_t*)(misc + OFF_WIN); j.dst2 = (bf16_t*)(misc + OFF_WVA); }
    else if (t < 2560) { const int q = t - 1792, w = q >> 8, tt = q & 255; j.src = w == 0 ? P.in[13] : w == 1 ? P.in[14] : P.in[15];
        j.dst = (bf16_t*)(misc + (w == 0 ? OFF_WA : w == 1 ? OFF_WB : OFF_WO)); j.Kdim = 1024; j.Ncols = 1024; j.tk = tt >> 4; j.tn = tt & 15; }
    else if (t < 3584) { const int q = t - 2560; j.src = P.in[18]; j.Kdim = 1024; j.Ncols = 4096; j.tk = q >> 6; j.tn = q & 63; j.dst = (bf16_t*)(misc + OFF_WF1); }
    else if (t < 4608) { const int q = t - 3584; j.src = P.in[19]; j.Kdim = 4096; j.Ncols = 1024; j.tk = q >> 4; j.tn = q & 15; j.dst = (bf16_t*)(misc + OFF_WF2); }
    else if (t < 4672) { const int q = t - 4608; j.src = P.in[21]; j.Kdim = 256; j.Ncols = 1024; j.tk = q >> 4; j.tn = q & 15; j.dst = (bf16_t*)(misc + OFF_WP); }
    else { const int q = t - 4672; j.src = P.in[22]; j.Kdim = 1024; j.Ncols = 1024; j.tk = q >> 4; j.tn = q & 15; j.dst = (bf16_t*)(misc + OFF_WG); }
    return j;
}
DI void tconv_load(const TJob& j, int tid, f32x4 (&v)[2]) {
    const int c4 = (tid & 15) * 4, r = tid >> 4;
#pragma unroll
    for (int i = 0; i < 2; ++i) v[i] = *(const f32x4*)(j.src + (size_t)(j.tk * 64 + r + 32 * i) * j.Ncols + j.tn * 64 + c4);
}
DI void tconv_finish(LAS float* tile, const TJob& j, int tid, const f32x4 (&v)[2]) {
    const int k0 = j.tk * 64, c0 = j.tn * 64;
    {
        const int c4 = (tid & 15) * 4, r = tid >> 4;
#pragma unroll
        for (int i = 0; i < 2; ++i) {
            const int rr = r + 32 * i;
            tile[(c4 + 0) * 65 + rr] = v[i][0]; tile[(c4 + 1) * 65 + rr] = v[i][1]; tile[(c4 + 2) * 65 + rr] = v[i][2]; tile[(c4 + 3) * 65 + rr] = v[i][3];
        }
    }
    __syncthreads();
    {
        const int cc = tid >> 3, r8 = (tid & 7) * 8;
        float f[8];
#pragma unroll
        for (int q = 0; q < 8; ++q) f[q] = tile[cc * 65 + r8 + q];
        u32x4 w; w.x = cvt_pk_bf16(f[0], f[1]); w.y = cvt_pk_bf16(f[2], f[3]); w.z = cvt_pk_bf16(f[4], f[5]); w.w = cvt_pk_bf16(f[6], f[7]);
        bf16_t* rowp = j.mode == 1 ? win_dstrow(c0 + cc, j.dst, j.dst2) : j.dst + (size_t)(c0 + cc) * j.Kdim;
        *(u32x4*)(rowp + k0 + r8) = w;
    }
}

DI void prologue(LAS unsigned char* lds, const Params& P, int G) {
    unsigned char* misc = P.ws + 7 * SLOT;
    const int tid = opaque_tid(), lane = tid & 63, wid = tid >> 6;
    {
        int t = blockIdx.x; int par = 0;
        TJob cur = tjob(P, misc, t); f32x4 v[2]; tconv_load(cur, tid, v);
        while (t < 4928) {
            const int tn_ = t + G; const bool hn = tn_ < 4928;
            TJob nx = cur; f32x4 vn[2] = {v[0], v[1]};
            if (hn) { nx = tjob(P, misc, tn_); tconv_load(nx, tid, vn); }
            tconv_finish((LAS float*)(lds + par * 16640), cur, tid, v);
            cur = nx; v[0] = vn[0]; v[1] = vn[1]; t = tn_; par ^= 1;
        }
        __syncthreads();
    }
    const size_t gtid = (size_t)blockIdx.x * 512 + tid, gthreads = (size_t)G * 512;
    {
        float* rope = (float*)(misc + OFF_ROPE);
        for (size_t i = gtid; i < (size_t)SEQ * 32; i += gthreads) {
            const int pos = (int)(i >> 5), f = (int)(i & 31);
            const float inv = 1.0f / powf(10000.0f, (float)(2 * f) / 64.0f);
            const float ang = (float)pos * inv;
            const double a = (double)ang; const double kq = __builtin_rint(a * 0.15915494309189535); const float rr = (float)(a - kq * 6.283185307179586);
            rope[2 * i] = cosf(rr); rope[2 * i + 1] = sinf(rr);
        }
    }
    { float* ss = (float*)(misc + OFF_SS); for (size_t i = gtid; i < (size_t)3 * MT; i += gthreads) ss[i] = 0.f; }
    {
        bf16_t* wsb = (bf16_t*)(misc + OFF_WS); const float* w = P.in[6];
        for (size_t i = gtid; i < (size_t)8 * 128 * 128; i += gthreads) {
            const int s = (int)(i & 127), t = (int)((i >> 7) & 127);
            const float v = ((s >> 6) <= (t >> 6)) ? w[i] : 0.f;
            wsb[i] = (bf16_t)(cvt_pk_bf16(v, 0.f) & 0xffffu);
        }
    }
    {
        const f32x4* p4 = (const f32x4*)P.in[1]; u32x2* pb = (u32x2*)(misc + OFF_PB);
        for (size_t i = gtid; i < (size_t)MT * PLED / 4; i += gthreads) { const f32x4 v = p4[i]; u32x2 w; w.x = cvt_pk_bf16(v[0], v[1]); w.y = cvt_pk_bf16(v[2], v[3]); pb[i] = w; }
    }
    {
        const float* x = P.in[0]; const float* g = P.in[2]; bf16_t* xn = (bf16_t*)(P.ws);
        f32x4 gv[4];
#pragma unroll
        for (int i = 0; i < 4; ++i) gv[i] = *(const f32x4*)(g + 256 * i + lane * 4);
        for (int row = blockIdx.x * 8 + wid; row < MT; row += G * 8) {
            f32x4 v[4]; float s = 0.f;
#pragma unroll
            for (int i = 0; i < 4; ++i) { v[i] = *(const f32x4*)(x + (size_t)row * DM + 256 * i + lane * 4); s += (v[i][0] * v[i][0] + v[i][1] * v[i][1]) + (v[i][2] * v[i][2] + v[i][3] * v[i][3]); }
            s = wave_sum(s);
            const float rs = rsqrtf(s * (1.0f / DM) + EPSV);
#pragma unroll
            for (int i = 0; i < 4; ++i) { u32x2 w; w.x = cvt_pk_bf16(v[i][0] * rs * gv[i][0], v[i][1] * rs * gv[i][1]); w.y = cvt_pk_bf16(v[i][2] * rs * gv[i][2], v[i][3] * rs * gv[i][3]);
                *(u32x2*)(xn + (size_t)row * DM + 256 * i + lane * 4) = w; }
        }
    }
}

DI void elementwise_phase(const Params& P, int which, int G) {
    unsigned char* misc = P.ws + 7 * SLOT;
    const int tid = opaque_tid(), lane = tid & 63, wid = tid >> 6;
    const float* ssb = (const float*)(misc + OFF_SS) + (size_t)which * MT;
    bf16_t* H = (bf16_t*)P.ws;
    const bf16_t* raw = which == 0 ? (const bf16_t*)(P.ws + 2 * SLOT) : which == 1 ? (const bf16_t*)P.out : (const bf16_t*)(P.ws + 4 * SLOT);
    const float* g1 = which == 0 ? P.in[16] : which == 1 ? P.in[20] : P.in[24];
    bf16_t* dstb = which == 0 ? (bf16_t*)P.out : (bf16_t*)(P.ws + 2 * SLOT);
    f32x4 gv[4], g2[4];
#pragma unroll
    for (int i = 0; i < 4; ++i) { const int col = 512 * (i >> 1) + lane * 8 + 4 * (i & 1); gv[i] = *(const f32x4*)(g1 + col); g2[i] = which == 0 ? *(const f32x4*)(P.in[17] + col) : (f32x4){1.f, 1.f, 1.f, 1.f}; }
    for (int row = blockIdx.x * 8 + wid; row < MT; row += G * 8) {
        const float rs = rsqrtf(ssb[row] * (1.0f / DM) + EPSV);
        f32x4 h[4]; float s = 0.f;
#pragma unroll
        for (int c = 0; c < 2; ++c) {
            const size_t o = (size_t)row * DM + 512 * c + lane * 8;
            f32x4 b0, b1;
            if (which == 0) { b0 = __builtin_nontemporal_load((const f32x4*)(P.in[0] + o)); b1 = __builtin_nontemporal_load((const f32x4*)(P.in[0] + o + 4)); }
            else { const u32x4 hw = *(const u32x4*)(H + o); b0 = (f32x4){bf_lo(hw.x), bf_hi(hw.x), bf_lo(hw.y), bf_hi(hw.y)}; b1 = (f32x4){bf_lo(hw.z), bf_hi(hw.z), bf_lo(hw.w), bf_hi(hw.w)}; }
            const u32x4 rw = __builtin_nontemporal_load((const u32x4*)(raw + o));
            const f32x4 r0 = {bf_lo(rw.x), bf_hi(rw.x), bf_lo(rw.y), bf_hi(rw.y)}, r1 = {bf_lo(rw.z), bf_hi(rw.z), bf_lo(rw.w), bf_hi(rw.w)};
            h[2 * c] = b0 + r0 * rs * gv[2 * c]; h[2 * c + 1] = b1 + r1 * rs * gv[2 * c + 1];
        }
#pragma unroll
        for (int i = 0; i < 4; ++i) s += (h[i][0] * h[i][0] + h[i][1] * h[i][1]) + (h[i][2] * h[i][2] + h[i][3] * h[i][3]);
        float rs2 = 1.0f;
        if (which == 0) { s = wave_sum(s); rs2 = rsqrtf(s * (1.0f / DM) + EPSV); }
#pragma unroll
        for (int c = 0; c < 2; ++c) {
            const size_t o = (size_t)row * DM + 512 * c + lane * 8;
            const f32x4 h0 = h[2 * c], h1 = h[2 * c + 1];
            if (which == 2) { *(f32x4*)(P.out + o) = h0; *(f32x4*)(P.out + o + 4) = h1; }
            else {
                u32x4 hw; hw.x = cvt_pk_bf16(h0[0], h0[1]); hw.y = cvt_pk_bf16(h0[2], h0[3]); hw.z = cvt_pk_bf16(h1[0], h1[1]); hw.w = cvt_pk_bf16(h1[2], h1[3]);
                *(u32x4*)(H + o) = hw;
                if (which == 0) { const f32x4 a0 = h0 * rs2 * g2[2 * c], a1 = h1 * rs2 * g2[2 * c + 1];
                    u32x4 w; w.x = cvt_pk_bf16(a0[0], a0[1]); w.y = cvt_pk_bf16(a0[2], a0[3]); w.z = cvt_pk_bf16(a1[0], a1[1]); w.w = cvt_pk_bf16(a1[2], a1[3]); *(u32x4*)(dstb + o) = w; }
                else *(u32x4*)(dstb + o) = hw;
            }
        }
    }
}

typedef short s16x4 __attribute__((ext_vector_type(4)));
DI void gmlp_phase(LAS unsigned char* lds, const Params& P, int G) {
    unsigned char* misc = P.ws + 7 * SLOT;
    const int tid = opaque_tid(), lane = tid & 63, wid = tid >> 6, fr = lane & 15, fq = lane >> 4;
    bf16_t* U = (bf16_t*)(P.ws + 1 * SLOT); const bf16_t* V = (const bf16_t*)(P.ws + 2 * SLOT);
    const bf16_t* WS = (const bf16_t*)(misc + OFF_WS);
    const float* lng = P.in[4]; const float* lnb = P.in[5]; const float* bs = P.in[7];
    LAS float* st = (LAS float*)lds;
    LAS unsigned char* vs = lds + 1024;
    constexpr int PV = 272;
    const int trq = fr >> 2, trp = fr & 3;
    for (int blk = blockIdx.x; blk < MT / 128; blk += G) {
        const size_t tok0 = (size_t)blk * 128;
        for (int r4 = 0; r4 < 4; ++r4) {
            float sm[4], sq[4];
#pragma unroll
            for (int e = 0; e < 4; ++e) {
                const bf16_t* vp = V + (tok0 + wid * 16 + r4 * 4 + e) * DM;
                const u32x4 a = *(const u32x4*)(vp + lane * 8), b2 = *(const u32x4*)(vp + 512 + lane * 8);
                float s0 = 0.f, q0 = 0.f;
#pragma unroll
                for (int j = 0; j < 4; ++j) { const float x0 = bf_lo(a[j]), x1 = bf_hi(a[j]), y0 = bf_lo(b2[j]), y1 = bf_hi(b2[j]); s0 += (x0 + x1) + (y0 + y1); q0 += (x0 * x0 + x1 * x1) + (y0 * y0 + y1 * y1); }
                sm[e] = s0; sq[e] = q0;
            }
#pragma unroll
            for (int o = 32; o >= 1; o >>= 1) {
#pragma unroll
                for (int e = 0; e < 4; ++e) { sm[e] += __shfl_xor(sm[e], o); sq[e] += __shfl_xor(sq[e], o); }
            }
            if (lane < 4) {
                const float s0 = lane == 0 ? sm[0] : lane == 1 ? sm[1] : lane == 2 ? sm[2] : sm[3];
                const float q0 = lane == 0 ? sq[0] : lane == 1 ? sq[1] : lane == 2 ? sq[2] : sq[3];
                const float mu = s0 * (1.0f / DM); const float var = fmaxf(q0 * (1.0f / DM) - mu * mu, 0.f);
                const int row = wid * 16 + r4 * 4 + lane; st[row * 2] = mu; st[row * 2 + 1] = rsqrtf(var + EPSV);
            }
        }
        u32x4 vreg[4];
#pragma unroll
        for (int i = 0; i < 4; ++i) { const int id = tid + 512 * i; vreg[i] = *(const u32x4*)(V + (tok0 + (id >> 4)) * DM + (id & 15) * 8); }
        u32x4 unext[4];
#pragma unroll
        for (int np = 0; np < 4; ++np) unext[np] = *(const u32x4*)(U + (tok0 + 16 * wid + fr) * DM + 32 * np + 8 * fq);
        __syncthreads();
        for (int g = 0; g < 8; ++g) {
#pragma unroll
            for (int i = 0; i < 4; ++i) {
                const int id = tid + 512 * i, sr = id >> 4, cc = (id & 15) * 8;
                const u32x4 v = vreg[i];
                const float mu = st[2 * sr], rs = st[2 * sr + 1];
                const f32x4 ga = *(const f32x4*)(lng + g * 128 + cc), gb = *(const f32x4*)(lng + g * 128 + cc + 4);
                const f32x4 ba = *(const f32x4*)(lnb + g * 128 + cc), bb = *(const f32x4*)(lnb + g * 128 + cc + 4);
                u32x4 w;
                w.x = cvt_pk_bf16((bf_lo(v.x) - mu) * rs * ga[0] + ba[0], (bf_hi(v.x) - mu) * rs * ga[1] + ba[1]);
                w.y = cvt_pk_bf16((bf_lo(v.y) - mu) * rs * ga[2] + ba[2], (bf_hi(v.y) - mu) * rs * ga[3] + ba[3]);
                w.z = cvt_pk_bf16((bf_lo(v.z) - mu) * rs * gb[0] + bb[0], (bf_hi(v.z) - mu) * rs * gb[1] + bb[1]);
                w.w = cvt_pk_bf16((bf_lo(v.w) - mu) * rs * gb[2] + bb[2], (bf_hi(v.w) - mu) * rs * gb[3] + bb[3]);
                *(LAS u32x4*)(vs + sr * PV + cc * 2) = w;
            }
            if (g < 7) {
#pragma unroll
                for (int i = 0; i < 4; ++i) { const int id = tid + 512 * i; vreg[i] = *(const u32x4*)(V + (tok0 + (id >> 4)) * DM + (g + 1) * 128 + (id & 15) * 8); }
            }
            const int t = 16 * wid + fr;
            bf16x8 wa[4];
#pragma unroll
            for (int kk = 0; kk < 4; ++kk) wa[kk] = *(const bf16x8*)(WS + (size_t)(g * 128 + t) * 128 + 32 * kk + 8 * fq);
            u32x4 uu[4];
#pragma unroll
            for (int np = 0; np < 4; ++np) uu[np] = unext[np];
            if (g < 7) {
#pragma unroll
                for (int np = 0; np < 4; ++np) unext[np] = *(const u32x4*)(U + (tok0 + t) * DM + (g + 1) * 128 + 32 * np + 8 * fq);
            }
            const float bsv = bs[g * 128 + t];
            __syncthreads();
            f32x4 acc[8];
#pragma unroll
            for (int n = 0; n < 8; ++n) acc[n] = (f32x4){0.f, 0.f, 0.f, 0.f};
#pragma unroll
            for (int kk = 0; kk < 4; ++kk) {
#pragma unroll
                for (int n = 0; n < 8; ++n) {
                    LAS unsigned char* ap = vs + (32 * kk + 8 * fq + trq) * PV + 64 * (n >> 1) + 16 * trp + 8 * (n & 1);
                    const s16x4 lo = __builtin_amdgcn_ds_read_tr16_b64_v4i16((LAS s16x4*)ap);
                    const s16x4 hi = __builtin_amdgcn_ds_read_tr16_b64_v4i16((LAS s16x4*)(ap + 4 * PV));
                    const bf16x8 bfr = __builtin_shufflevector(lo, hi, 0, 1, 2, 3, 4, 5, 6, 7);
                    acc[n] = __builtin_amdgcn_mfma_f32_16x16x32_bf16(bfr, wa[kk], acc[n], 0, 0, 0);
                }
            }
#pragma unroll
            for (int np = 0; np < 4; ++np) {
                bf16_t* up = U + (tok0 + t) * DM + g * 128 + 32 * np + 8 * fq;
                const f32x4 a0 = acc[2 * np], a1 = acc[2 * np + 1]; const u32x4 u4 = uu[np];
                u32x4 w;
                w.x = cvt_pk_bf16(bf_lo(u4.x) * (a0[0] + bsv), bf_hi(u4.x) * (a0[1] + bsv)); w.y = cvt_pk_bf16(bf_lo(u4.y) * (a0[2] + bsv), bf_hi(u4.y) * (a0[3] + bsv));
                w.z = cvt_pk_bf16(bf_lo(u4.z) * (a1[0] + bsv), bf_hi(u4.z) * (a1[1] + bsv)); w.w = cvt_pk_bf16(bf_lo(u4.w) * (a1[2] + bsv), bf_hi(u4.w) * (a1[3] + bsv));
                *(u32x4*)up = w;
            }
            __syncthreads();
        }
    }
}

constexpr int ATT_KBUF = 16384, ATT_KCOMP = 8192, ATT_VBASE = 4 * ATT_KBUF, ATT_VBUF = 16384, ATT_XOFF = 0;
DI bf16x8 pack8(const f32x16& s, int b) {
    u32x4 p; p.x = cvt_pk_bf16(s[b + 0], s[b + 1]); p.y = cvt_pk_bf16(s[b + 2], s[b + 3]); p.z = cvt_pk_bf16(s[b + 4], s[b + 5]); p.w = cvt_pk_bf16(s[b + 6], s[b + 7]);
    return __builtin_bit_cast(bf16x8, p);
}
DI bf16x8 att_kfrag(LAS const unsigned char* Kb, int rowoff, int kk, int yb) { return *(LAS const bf16x8*)(Kb + rowoff + ((32 * kk) ^ yb)); }
DI bf16x8 att_vfrag(LAS const unsigned char* Vb, int d, int rowoff, int ks, int yb) { return *(LAS const bf16x8*)(Vb + d * 4096 + rowoff + ((32 * ks) ^ yb)); }
DI float att_rowmax1(const f32x16& S) {
    float mx = fmaxf(S[0], S[1]);
#pragma unroll
    for (int i = 2; i < 16; i += 2) mx = fmaxf(fmaxf(mx, S[i]), S[i + 1]);
    return xhalf_max(mx);
}
template <bool HAS_NEXT>
DI void att_half(f32x16& C, f32x16& N, f32x16 (&o)[4], const bf16x8 (&qf)[4], f32x16& negm, float& lrun, float& cmx,
                 LAS const unsigned char* Kn, LAS const unsigned char* Vb, int ks0, int kro, int kyb, int vro, int vyb) {
    if (__builtin_amdgcn_ballot_w64(cmx > 6.0f) != 0ull) {
        const float dlt = fmaxf(cmx, 0.f); const float sc = fast_exp2(-dlt); lrun *= sc;
#pragma unroll
        for (int i = 0; i < 16; ++i) { C[i] -= dlt; negm[i] -= dlt; }
#pragma unroll
        for (int d = 0; d < 4; ++d)
#pragma unroll
            for (int i = 0; i < 16; ++i) o[d][i] *= sc;
    }
    float ps = 0.f;
    bf16x8 vf[4];
    if (HAS_NEXT) {
        bf16x8 kf[2];
        kf[0] = att_kfrag(Kn, kro, 0, kyb);
#pragma unroll
        for (int kk = 0; kk < 4; ++kk) {
            if (kk < 3) kf[(kk + 1) & 1] = att_kfrag(Kn, kro, kk + 1, kyb);
            if (kk == 3) {
#pragma unroll
                for (int d = 0; d < 4; ++d) vf[d] = att_vfrag(Vb, d, vro, ks0, vyb);
            }
            N = __builtin_amdgcn_mfma_f32_32x32x16_bf16(kf[kk & 1], qf[kk], kk == 0 ? negm : N, 0, 0, 0);
#pragma unroll
            for (int i = 4 * kk; i < 4 * kk + 4; ++i) { C[i] = fast_exp2(C[i]); ps += C[i]; }
            __builtin_amdgcn_sched_barrier(0);
        }
    } else {
#pragma unroll
        for (int d = 0; d < 4; ++d) vf[d] = att_vfrag(Vb, d, vro, ks0, vyb);
#pragma unroll
        for (int i = 0; i < 16; ++i) { C[i] = fast_exp2(C[i]); ps += C[i]; }
    }
    lrun += ps;
    bf16x8 pf[2]; pf[0] = pack8(C, 0); pf[1] = pack8(C, 8);
#pragma unroll
    for (int d = 0; d < 4; ++d) o[d] = __builtin_amdgcn_mfma_f32_32x32x16_bf16(vf[d], pf[0], o[d], 0, 0, 0);
    __builtin_amdgcn_sched_barrier(0);
    bf16x8 vg[4];
#pragma unroll
    for (int d = 0; d < 4; ++d) vg[d] = att_vfrag(Vb, d, vro, ks0 + 1, vyb);
    if (HAS_NEXT) {
        float pm = fmaxf(N[0], N[1]);
#pragma unroll
        for (int i = 2; i < 16; i += 2) pm = fmaxf(fmaxf(pm, N[i]), N[i + 1]);
        cmx = xhalf_max(pm);
    }
#pragma unroll
    for (int d = 0; d < 4; ++d) o[d] = __builtin_amdgcn_mfma_f32_32x32x16_bf16(vg[d], pf[1], o[d], 0, 0, 0);
    __builtin_amdgcn_sched_barrier(0);
}
#define ATT_DMA_K(KT, BUF) do { _Pragma("unroll") for (int i = 0; i < 2; ++i) \
    __builtin_amdgcn_global_load_lds((const unsigned*)(kgp[i] + (size_t)(KT) * 64 * 128), (LAS unsigned*)(lds + (BUF) * ATT_KBUF + (wid * 2 + i) * 1024), 16, 0, 0); } while (0)
#define ATT_DMA_V(KT, BUF) do { _Pragma("unroll") for (int i = 0; i < 2; ++i) \
    __builtin_amdgcn_global_load_lds((const unsigned*)(vgp[i] + (size_t)(KT) * 8192), (LAS unsigned*)(lds + ATT_VBASE + (BUF) * ATT_VBUF + (wid * 2 + i) * 1024), 16, 0, 0); } while (0)

DI void att_tile_id(int idx, int G, int& b, int& h, int& qt) {
    const int u = blockIdx.x + (idx >> 1) * G;
    const int k = u / 256, w = u % 256, bh = k * 8 + (w & 7), j = w >> 3;
    b = bh >> 3; h = bh & 7; qt = (idx & 1) ? j : 63 - j;
}
DI void attn_phase(LAS unsigned char* lds, const Params& P, int G) {
    const bf16_t* Qg = (const bf16_t*)(P.ws + 3 * SLOT); const bf16_t* Kg = (const bf16_t*)(P.ws + 4 * SLOT); const bf16_t* Vtg = (const bf16_t*)(P.ws + 5 * SLOT);
    bf16_t* Og = (bf16_t*)(P.ws + 3 * SLOT);
    const float* subg = P.in[12];
    float d1 = 0.f, d2 = 0.f;
    for (int i = 0; i < 64; ++i) { d1 += P.in[8][i] * P.in[9][i]; d2 += P.in[10][i] * P.in[11][i]; }
    const float lam = expf(d1) - expf(d2) + 0.2f;
    const int tid = opaque_tid(), lane = tid & 63, wid = __builtin_amdgcn_readfirstlane(tid >> 6);
    const int comp = wid & 1, rg = wid >> 1, r = lane & 31, h2 = lane >> 5;
    const int pr = (r & 19) | ((r & 4) << 1) | ((r & 8) >> 1);
    const int kro = pr * 128, kyb = 16 * (h2 ^ ((pr >> 1) & 7)), vro = r * 128, vyb = 16 * (h2 ^ ((r >> 1) & 7));
    int ntiles = 0; for (int u = blockIdx.x; u < 2048; u += G) ntiles += 2;
#define ATT_BARV(N) do { asm volatile("s_waitcnt vmcnt(" #N ") lgkmcnt(0)" ::: "memory"); __builtin_amdgcn_s_barrier(); asm volatile("" ::: "memory"); } while (0)
#define ATT_BARL() do { asm volatile("s_waitcnt lgkmcnt(0)" ::: "memory"); __builtin_amdgcn_s_barrier(); asm volatile("" ::: "memory"); } while (0)
#define ATT_SETUP(B_, H_, QT_, KGP, VGP, QF) do { \
    _Pragma("unroll") for (int i = 0; i < 2; ++i) { \
        const int j = wid * 2 + i; \
        const int krow = (j & 7) * 8 + (lane >> 3), kc = (lane & 7) ^ ((krow >> 1) & 7); \
        KGP[i] = Kg + ((size_t)((B_) * 8 + (H_)) * SEQ + krow) * 128 + (j >> 3) * 64 + kc * 8; \
        const int d = j * 8 + (lane >> 3), vc = (lane & 7) ^ ((d >> 1) & 7); \
        VGP[i] = Vtg + (size_t)((B_) * 8 + (H_)) * 128 * 8192 + d * 64 + vc * 8; } \
    const bf16_t* qp = Qg + ((size_t)(B_) * SEQ + (QT_) * 128 + rg * 32 + r) * DM + (H_) * 128 + comp * 64 + 8 * h2; \
    _Pragma("unroll") for (int kk = 0; kk < 4; ++kk) QF[kk] = *(const bf16x8*)(qp + 16 * kk); } while (0)
    if (ntiles == 0) return;
    int b, h, qt; att_tile_id(0, G, b, h, qt);
    const bf16_t* kgp[2]; const bf16_t* vgp[2]; bf16x8 qf[4];
    ATT_SETUP(b, h, qt, kgp, vgp, qf);
    ATT_DMA_K(0, 0); ATT_DMA_K(1, 1); if (qt > 0) ATT_DMA_K(2, 2);
    for (int idx = 0; idx < ntiles; ++idx) {
        const int q0 = qt * 128 + rg * 32;
        const int nkt = 2 * qt + 2, nkt_w = 2 * qt + (rg >> 1) + 1;
        const size_t tokbase = (size_t)b * SEQ;
        ATT_DMA_V(0, 0); ATT_DMA_V(1, 1);
        ATT_BARV(2);
        f32x16 o[4];
#pragma unroll
        for (int d = 0; d < 4; ++d)
#pragma unroll
            for (int i = 0; i < 16; ++i) o[d][i] = 0.f;
        float lrun = 0.f;
        f32x16 sA, sB, negm; float cmx;
        {
            LAS const unsigned char* Kb0 = lds + comp * ATT_KCOMP;
            f32x16 z;
#pragma unroll
            for (int i = 0; i < 16; ++i) z[i] = 0.f;
            sA = z;
#pragma unroll
            for (int kk = 0; kk < 4; ++kk) sA = __builtin_amdgcn_mfma_f32_32x32x16_bf16(att_kfrag(Kb0, kro, kk, kyb), qf[kk], sA, 0, 0, 0);
            const float m0 = att_rowmax1(sA);
#pragma unroll
            for (int i = 0; i < 16; ++i) { sA[i] -= m0; negm[i] = -m0; }
            cmx = 0.f;
            sB = z;
        }
        int vb_cur = 0, vb_fill = 2;
        for (int kt = 0; kt < nkt - 1; ++kt) {
            const bool dk = (kt + 3 < nkt), dv = (kt + 2 < nkt);
            if (dk) ATT_DMA_K(kt + 3, (kt + 3) & 3);
            LAS const unsigned char* Vb = lds + ATT_VBASE + vb_cur * ATT_VBUF;
            att_half<true>(sA, sB, o, qf, negm, lrun, cmx, lds + (kt & 3) * ATT_KBUF + comp * ATT_KCOMP + 4096, Vb, 0, kro, kyb, vro, vyb);
            if (dv) ATT_DMA_V(kt + 2, vb_fill);
            att_half<true>(sB, sA, o, qf, negm, lrun, cmx, lds + ((kt + 1) & 3) * ATT_KBUF + comp * ATT_KCOMP, Vb, 2, kro, kyb, vro, vyb);
            vb_cur = (vb_cur == 2) ? 0 : vb_cur + 1; vb_fill = (vb_fill == 2) ? 0 : vb_fill + 1;
            if (dk) ATT_BARV(4); else if (dv) ATT_BARV(2); else ATT_BARV(0);
        }
        if (nkt_w == nkt) {
            LAS const unsigned char* Vb = lds + ATT_VBASE + vb_cur * ATT_VBUF;
            att_half<true>(sA, sB, o, qf, negm, lrun, cmx, lds + ((nkt - 1) & 3) * ATT_KBUF + comp * ATT_KCOMP + 4096, Vb, 0, kro, kyb, vro, vyb);
            att_half<false>(sB, sA, o, qf, negm, lrun, cmx, lds + (nkt & 3) * ATT_KBUF + comp * ATT_KCOMP, Vb, 2, kro, kyb, vro, vyb);
        }
        ATT_BARV(0);
        int nb = b, nh = h, nqt = qt; const bool has_next = idx + 1 < ntiles;
        const bf16_t* kgn[2] = {kgp[0], kgp[1]}; const bf16_t* vgn[2] = {vgp[0], vgp[1]}; bf16x8 qn[4] = {qf[0], qf[1], qf[2], qf[3]};
        if (has_next) {
            att_tile_id(idx + 1, G, nb, nh, nqt);
            ATT_SETUP(nb, nh, nqt, kgn, vgn, qn);
            { const bf16_t* const* kgp_s = kgn; (void)kgp_s; }
#define kgp kgn
            ATT_DMA_K(0, 0); ATT_DMA_K(1, 1); if (nqt > 0) ATT_DMA_K(2, 2);
#undef kgp
        }
        const float ltot = lrun + __shfl_xor(lrun, 32);
        const float inv = 1.0f / ltot;
        LAS float* xs = (LAS float*)(lds + 65536) + rg * 4096;
        if (comp == 1) {
#pragma unroll
            for (int d = 0; d < 4; ++d)
#pragma unroll
                for (int i = 0; i < 16; ++i) xs[(d * 16 + i) * 64 + lane] = o[d][i] * inv;
        }
        ATT_BARL();
        if (comp == 0) {
            float ssq = 0.f;
#pragma unroll
            for (int d = 0; d < 4; ++d)
#pragma unroll
                for (int i = 0; i < 16; ++i) { const float v = o[d][i] * inv - lam * xs[(d * 16 + i) * 64 + lane]; o[d][i] = v; ssq += v * v; }
            ssq += __shfl_xor(ssq, 32);
            const float rs = rsqrtf(ssq * (1.0f / 128.0f) + EPSV) * 0.8f;
            bf16_t* op = Og + (tokbase + q0 + r) * DM + h * 128;
#pragma unroll
            for (int d = 0; d < 4; ++d)
#pragma unroll
                for (int k2 = 0; k2 < 2; ++k2) {
                    u32x2 wa, wb;
                    { const int g4 = 2 * k2, dd = 32 * d + 8 * g4 + 4 * h2; const f32x4 gg = *(const f32x4*)(subg + dd);
                      wa.x = cvt_pk_bf16(o[d][4 * g4 + 0] * rs * gg[0], o[d][4 * g4 + 1] * rs * gg[1]); wa.y = cvt_pk_bf16(o[d][4 * g4 + 2] * rs * gg[2], o[d][4 * g4 + 3] * rs * gg[3]); }
                    { const int g4 = 2 * k2 + 1, dd = 32 * d + 8 * g4 + 4 * h2; const f32x4 gg = *(const f32x4*)(subg + dd);
                      wb.x = cvt_pk_bf16(o[d][4 * g4 + 0] * rs * gg[0], o[d][4 * g4 + 1] * rs * gg[1]); wb.y = cvt_pk_bf16(o[d][4 * g4 + 2] * rs * gg[2], o[d][4 * g4 + 3] * rs * gg[3]); }
                    const auto sx = __builtin_amdgcn_permlane32_swap(wa.x, wb.x, false, false);
                    const auto sy = __builtin_amdgcn_permlane32_swap(wa.y, wb.y, false, false);
                    u32x4 w; w.x = sx[0]; w.y = sy[0]; w.z = sx[1]; w.w = sy[1];
                    *(u32x4*)(op + 32 * d + 16 * k2 + 8 * h2) = w;
                }
        }
        ATT_BARL();
        b = nb; h = nh; qt = nqt;
#pragma unroll
        for (int i = 0; i < 2; ++i) { kgp[i] = kgn[i]; vgp[i] = vgn[i]; }
#pragma unroll
        for (int kk = 0; kk < 4; ++kk) qf[kk] = qn[kk];
    }
    asm volatile("s_waitcnt vmcnt(0)" ::: "memory");
#undef ATT_BARV
#undef ATT_BARL
#undef ATT_SETUP
}

#define XB_TMO      128
#define XB_XCNT(j)  (256  + 64 * (j))
#define XB_XSUB(j)  (1280 + 64 * (j))
#define XB_XGEN(j)  (2304 + 64 * (j))
#define XB_TOP      3328
#define XB_TOPGEN   3392
#define XCD_BAR_WORDS 3456
#define XB_SPIN_CAP (1u << 22)
DI unsigned xb_ld(unsigned* p)              { return __hip_atomic_load(p, __ATOMIC_RELAXED, __HIP_MEMORY_SCOPE_AGENT); }
DI unsigned xb_add(unsigned* p, unsigned v) { return __hip_atomic_fetch_add(p, v, __ATOMIC_RELAXED, __HIP_MEMORY_SCOPE_AGENT); }
DI unsigned xb_xcc_id() { return (unsigned)__builtin_amdgcn_s_getreg((3 << 11) | 20) & 0xFu; }
#define XB_SPIN(cond, bar) do { unsigned _sp = 0; while (cond) { __builtin_amdgcn_s_sleep(1); \
    if ((++_sp & 255u) == 0u) { if (xb_ld(&(bar)[XB_TMO])) break; if (_sp > XB_SPIN_CAP) { atomicAdd(&(bar)[XB_TMO], 1u); break; } } } } while (0)
struct XcdBarrier { unsigned* bar; unsigned x; volatile LAS unsigned* st; };
DI XcdBarrier xcd_barrier_post(unsigned* bar, volatile LAS unsigned* st) {
    XcdBarrier b; b.bar = bar; b.x = xb_xcc_id(); b.st = st;
    if (threadIdx.x == 0) (void)xb_add(&bar[XB_XCNT(b.x)], 1u);
    return b;
}
DI void xcd_barrier_complete(unsigned* bar, unsigned x, unsigned& nloc, unsigned& nx) {
    const unsigned G = gridDim.x * gridDim.y * gridDim.z;
    unsigned sum, cnt, mine, sp = 0u;
    for (;;) {
        sum = 0u; cnt = 0u; mine = 0u;
#pragma unroll
        for (unsigned j = 0; j < 16; ++j) { const unsigned c = xb_ld(&bar[XB_XCNT(j)]); sum += c; cnt += (c > 0u) ? 1u : 0u; mine = (j == x) ? c : mine; }
        if (sum == G) break;
        __builtin_amdgcn_s_sleep(1);
        if ((++sp & 255u) == 0u) { if (xb_ld(&bar[XB_TMO])) break; if (sp > XB_SPIN_CAP) { atomicAdd(&bar[XB_TMO], 1u); break; } }
    }
    nloc = mine > 0u ? mine : 1u; nx = cnt > 0u ? cnt : 1u;
}
DI void xcd_barrier(const XcdBarrier& b) {
    asm volatile("s_waitcnt vmcnt(0)" ::: "memory");
    __syncthreads();
    if (threadIdx.x == 0) {
        unsigned* bar = b.bar;
        __builtin_amdgcn_s_waitcnt(0);
        unsigned nloc = b.st[0], nx = b.st[1];
        if (nloc == 0u) { xcd_barrier_complete(bar, b.x, nloc, nx); b.st[0] = nloc; b.st[1] = nx; }
        const unsigned old = xb_add(&bar[XB_XSUB(b.x)], 1u);
        const unsigned gen = old / nloc;
        if (old + 1u == (gen + 1u) * nloc) {
            __builtin_amdgcn_fence(__ATOMIC_RELEASE, "agent");
            asm volatile("s_waitcnt vmcnt(0)" ::: "memory");
            const unsigned og = xb_add(&bar[XB_TOP], 1u);
            const unsigned tg = og / nx;
            if (og + 1u == (tg + 1u) * nx) xb_add(&bar[XB_TOPGEN], 1u);
            else XB_SPIN(xb_ld(&bar[XB_TOPGEN]) == tg, bar);
            __builtin_amdgcn_fence(__ATOMIC_ACQUIRE, "agent");
            xb_add(&bar[XB_XGEN(b.x)], 1u);
            asm volatile("s_waitcnt vmcnt(0)" ::: "memory");
        } else {
            XB_SPIN(xb_ld(&bar[XB_XGEN(b.x)]) == gen, bar);
            __builtin_amdgcn_fence(__ATOMIC_ACQUIRE, "agent");
            asm volatile("s_waitcnt vmcnt(0)" ::: "memory");
        }
    }
    __syncthreads();
}

DI GemmJob make_job(const Params& P, int ph, int g) {
    unsigned char* ws = P.ws; unsigned char* misc = ws + 7 * SLOT;
    GemmJob J{};
    J.ldc = DM; J.rope = (const float*)(misc + OFF_ROPE);
    if (ph == 1 && g == 0) { J.A = (const bf16_t*)ws; J.Bt = (const bf16_t*)(misc + OFF_WIN); J.M = MT; J.N = 6144; J.K = DM; J.mode = EPI_IN; J.in_base = (bf16_t*)(ws + SLOT); J.gb_base = (bf16_t*)P.out; }
    else if (ph == 1) { J.A = (const bf16_t*)(misc + OFF_WVA); J.Bt = (const bf16_t*)ws; J.M = 1024; J.N = MT; J.K = DM; J.mode = EPI_VT; J.o0 = (bf16_t*)(ws + 5 * SLOT); J.ldc = MT; }
    else if (ph == 3 && g == 0) { J.A = (const bf16_t*)(ws + SLOT); J.Bt = (const bf16_t*)(misc + OFF_WA); J.M = MT; J.N = DM; J.K = DM; J.mode = EPI_BRA; J.o0 = (bf16_t*)(ws + 6 * SLOT); }
    else if (ph == 3) { J.A = (const bf16_t*)(ws + 3 * SLOT); J.Bt = (const bf16_t*)(misc + OFF_WB); J.M = MT; J.N = DM; J.K = DM; J.mode = EPI_BRB; J.o0 = (bf16_t*)P.out; J.i0 = (const bf16_t*)(ws + 6 * SLOT); }
    else if (ph == 4) { J.A = (const bf16_t*)P.out; J.Bt = (const bf16_t*)(misc + OFF_WO); J.M = MT; J.N = DM; J.K = DM; J.mode = EPI_RAW; J.fo = (float*)(ws + 2 * SLOT); J.ss = (float*)(misc + OFF_SS); }
    else if (ph == 6) { J.A = (const bf16_t*)P.out; J.Bt = (const bf16_t*)(misc + OFF_WF1); J.M = MT; J.N = FFW; J.K = DM; J.mode = EPI_RELU2; J.o0 = (bf16_t*)(ws + 3 * SLOT); J.ldc = FFW; }
    else if (ph == 7) { J.A = (const bf16_t*)(ws + 3 * SLOT); J.Bt = (const bf16_t*)(misc + OFF_WF2); J.M = MT; J.N = DM; J.K = FFW; J.mode = EPI_RAW; J.fo = P.out; J.ss = (float*)(misc + OFF_SS) + MT; }
    else if (ph == 9 && g == 0) { J.A = (const bf16_t*)(misc + OFF_PB); J.Bt = (const bf16_t*)(misc + OFF_WP); J.M = MT; J.N = DM; J.K = PLED; J.mode = EPI_BF16; J.o0 = (bf16_t*)(ws + 3 * SLOT); }
    else { J.A = (const bf16_t*)(ws + 2 * SLOT); J.Bt = (const bf16_t*)(misc + OFF_WG); J.M = MT; J.N = DM; J.K = DM; J.mode = EPI_GATE; J.fo = (float*)(ws + 4 * SLOT); J.ss = (float*)(misc + OFF_SS) + 2 * MT;
           J.i0 = (const bf16_t*)(ws + 3 * SLOT); J.bias = P.in[23]; }
    return J;
}

__global__ void __launch_bounds__(512, 2) mega_fwd(Params P) {
    extern __shared__ __attribute__((aligned(16))) unsigned char lds_raw[];
    LAS unsigned char* lds = (LAS unsigned char*)lds_raw;
    cg::grid_group grid = cg::this_grid();
    const int G = gridDim.x;
    volatile LAS unsigned* stw = (volatile LAS unsigned*)(lds + 131072);
    if (threadIdx.x < 4) stw[threadIdx.x] = 0u;
    __syncthreads();
    const XcdBarrier xb = xcd_barrier_post((unsigned*)(P.ws + 7 * SLOT + OFF_BAR), stw);
    for (int ph = P.ph_lo; ph < P.ph_hi; ++ph) {
        if (ph > P.ph_lo) {
            if (P.ph_lo != 0) grid.sync();
            else xcd_barrier(xb);
        }
        int ngemm = 0;
        if (ph == 0) { if (PHMASK & 1) prologue(lds, P, G); }
        else if (ph == 2) { if (PHMASK & 2) gmlp_phase(lds, P, G); if (PHMASK & 4) attn_phase(lds, P, G); }
        else if (ph == 5) { if (PHMASK & 8) elementwise_phase(P, 0, G); }
        else if (ph == 8) { if (PHMASK & 8) elementwise_phase(P, 1, G); }
        else if (ph == 10) { if (PHMASK & 8) elementwise_phase(P, 2, G); }
        else ngemm = (ph == 1 || ph == 3 || ph == 9) ? 2 : 1;
        if (PHMASK & 16) for (int g = 0; g < ngemm; ++g) {
            const GemmJob J = make_job(P, ph, g);
            gemm_phase(lds, J, G, blockIdx.x);
        }
    }
}

extern "C" void kernel_launch(void* const* d_in, const int* in_sizes, int n_in, void* d_out, int out_size, void* d_ws, size_t ws_size, hipStream_t stream) {
    static int grid_blocks = 0;
    if (!grid_blocks) {
        int dev = 0, cus = 0, per_cu = 0;
        hipGetDevice(&dev);
        hipDeviceGetAttribute(&cus, hipDeviceAttributeMultiprocessorCount, dev);
        if (hipFuncSetAttribute((const void*)mega_fwd, hipFuncAttributeMaxDynamicSharedMemorySize, LDS_BYTES) != hipSuccess) fprintf(stderr, "hipFuncSetAttribute failed\n");
        hipOccupancyMaxActiveBlocksPerMultiprocessor(&per_cu, (const void*)mega_fwd, 512, LDS_BYTES);
        if (per_cu < 1) { fprintf(stderr, "occupancy query returned %d\n", per_cu); per_cu = 1; }
        grid_blocks = cus * per_cu;
        if (ws_size < 8 * SLOT) fprintf(stderr, "workspace too small: %zu\n", ws_size);
    }
    Params p{};
    for (int i = 0; i < 25; ++i) p.in[i] = (const float*)d_in[i];
    p.out = (float*)d_out; p.ws = (unsigned char*)d_ws; p.ph_lo = 0; p.ph_hi = NPHASE;
    if (hipMemsetAsync((char*)d_ws + 7 * SLOT + OFF_BAR, 0, 16384, stream) != hipSuccess) fprintf(stderr, "hipMemsetAsync of the barrier words failed\n");
    void* args[] = {&p};
    hipError_t e = hipLaunchCooperativeKernel((const void*)mega_fwd, dim3(grid_blocks), dim3(512), args, LDS_BYTES, stream);
    if (e != hipSuccess) fprintf(stderr, "cooperative launch failed: %s (grid %d)\n", hipGetErrorString(e), grid_blocks);
}
```

```cpp
#include <hip/hip_runtime.h>
#include <hip/hip_cooperative_groups.h>
#include <cstdio>
namespace cg = cooperative_groups;

#define LAS __attribute__((address_space(3)))
#define DI __device__ __forceinline__
typedef unsigned short bf16_t;
typedef short bf16x8 __attribute__((ext_vector_type(8)));
typedef float f32x4 __attribute__((ext_vector_type(4)));
typedef float f32x16 __attribute__((ext_vector_type(16)));
typedef unsigned u32x4 __attribute__((ext_vector_type(4)));
typedef unsigned u32x2 __attribute__((ext_vector_type(2)));

constexpr int MT = 65536, DM = 1024, SEQ = 8192, FFW = 4096, PLED = 256;
constexpr float EPSV = 1e-6f;
constexpr size_t SLOT = (size_t)1 << 27;
constexpr size_t OFF_WIN = 0;
constexpr size_t OFF_WVA = OFF_WIN + (size_t)6144 * 1024 * 2;
constexpr size_t OFF_WA = OFF_WVA + (size_t)1024 * 1024 * 2;
constexpr size_t OFF_WB = OFF_WA + (size_t)1024 * 1024 * 2;
constexpr size_t OFF_WO = OFF_WB + (size_t)1024 * 1024 * 2;
constexpr size_t OFF_WF1 = OFF_WO + (size_t)1024 * 1024 * 2;
constexpr size_t OFF_WF2 = OFF_WF1 + (size_t)4096 * 1024 * 2;
constexpr size_t OFF_WP = OFF_WF2 + (size_t)4096 * 1024 * 2;
constexpr size_t OFF_WG = OFF_WP + (size_t)1024 * 256 * 2;
constexpr size_t OFF_ROPE = OFF_WG + (size_t)1024 * 1024 * 2;
constexpr size_t OFF_SS = OFF_ROPE + (size_t)8192 * 32 * 8;
constexpr size_t OFF_WS = OFF_SS + (size_t)3 * 65536 * 4;
constexpr size_t OFF_PB = OFF_WS + (size_t)8 * 128 * 128 * 2;
constexpr size_t OFF_END = OFF_PB + (size_t)65536 * 256 * 2;
constexpr size_t OFF_BAR = OFF_END;
static_assert(OFF_BAR + 16384 <= SLOT, "misc region overflow");

constexpr int LDS_BYTES = 131072 + 16;
constexpr int NPHASE = 11;
#ifndef STAGGER_TICKS
#define STAGGER_TICKS 700
#endif
#ifndef PHMASK
#define PHMASK 31
#endif

struct Params {
    const float* in[25];
    float* out;
    unsigned char* ws;
    int ph_lo, ph_hi;
};

typedef __bf16 bf16x2n __attribute__((ext_vector_type(2)));
typedef float f32x2n __attribute__((ext_vector_type(2)));
DI unsigned cvt_pk_bf16(float lo, float hi) { const f32x2n v = {lo, hi}; return __builtin_bit_cast(unsigned, __builtin_convertvector(v, bf16x2n)); }
DI float bf_lo(unsigned w) { return __uint_as_float(w << 16); }
DI float bf_hi(unsigned w) { return __uint_as_float(w & 0xffff0000u); }
DI float fast_exp2(float x) { return __builtin_amdgcn_exp2f(x); }
DI float fast_rcp(float x) { return __builtin_amdgcn_rcpf(x); }
DI float sigmoid_f(float x) { return fast_rcp(1.0f + fast_exp2(-1.4426950408889634f * x)); }
DI float gelu_tanh(float x) { const float u = x * (0.7978845608028654f + 0.035677408136300125f * x * x); return x * fast_rcp(1.0f + fast_exp2(-2.885390081777927f * u)); }
DI int opaque_tid() { int t = threadIdx.x; asm volatile("" : "+v"(t)); return t; }
DI float xhalf_max(float x) { const auto r = __builtin_amdgcn_permlane32_swap(__float_as_uint(x), __float_as_uint(x), false, false); return fmaxf(__uint_as_float(r[0]), __uint_as_float(r[1])); }
DI float wave_sum(float v) { v += __shfl_xor(v, 32); v += __shfl_xor(v, 16); v += __shfl_xor(v, 8); v += __shfl_xor(v, 4); v += __shfl_xor(v, 2); v += __shfl_xor(v, 1); return v; }

constexpr int BM = 256, BK = 64, HALF = 128, HTB = HALF * BK * 2, NXCD = 8, WGM = 8;
DI int lds_byte(int r, int c) { const int st = (r >> 4) * 2 + (c >> 5), rr = r & 15, cc = c & 31, ob = rr * 64 + cc * 2; return st * 1024 + (ob ^ (((ob >> 9) & 1) << 5)); }
DI void stage_rc(int b, int& R, int& C) { const int st = b / 1024, sb = b % 1024, swz = sb ^ (((sb >> 9) & 1) << 5); R = (st >> 1) * 16 + swz / 64; C = (st & 1) * 32 + (swz % 64) / 2; }
DI int perm32(int rho) { const int n = rho >> 4, i = rho & 15; return 8 * (i >> 2) + 4 * n + (i & 3); }
struct Unit { int pm, pn; };
struct StaticOrder {
    int nM, nN, nwg, G, c;
    DI void init(int M, int N, int G_, int c_) { nM = M / BM; nN = N / BM; nwg = nM * nN; G = G_; c = c_; }
    DI bool next(int i, Unit& u) const {
        const long L = (long)i * G + c; if (L >= nwg) return false;
        int wgid = (int)L; { const int q = nwg / NXCD, r = nwg % NXCD, xcd = wgid % NXCD, off = wgid / NXCD; wgid = (xcd < r ? xcd * (q + 1) : r * (q + 1) + (xcd - r) * q) + off; }
        const int nig = WGM * nN, gid = wgid / nig, fm = gid * WGM, gsz = (nM - fm) < WGM ? (nM - fm) : WGM;
        u.pm = fm + ((wgid % nig) % gsz); u.pn = (wgid % nig) / gsz; return true;
    }
};

enum { EPI_IN = 0, EPI_BF16 = 1, EPI_BRA = 2, EPI_BRB = 3, EPI_RAW = 4, EPI_RELU2 = 5, EPI_GATE = 6, EPI_VT = 7 };
struct GemmJob {
    const bf16_t* A; const bf16_t* Bt; int M, N, K; int mode;
    bf16_t* o0; int ldc;
    const bf16_t* i0;
    float* fo; float* ss; const float* bias;
    bf16_t* in_base;
    bf16_t* gb_base;
    const float* rope;
};

constexpr float QSCALE = 0.125f * 1.4426950408889634f;

DI void epilogue(const f32x4 (&acc)[2][2][4][2], const Unit& u, int wr, int wc, int fr, int fq, const GemmJob& J) {
    const int mode = J.mode;
    if (mode == EPI_IN) {
        const int region = u.pn >> 2;
        bf16_t* base = region == 0 ? J.in_base : region == 1 ? J.in_base + (SLOT / 2) : region == 2 ? J.in_base + 2 * (SLOT / 2) : region == 3 ? J.in_base + 3 * (SLOT / 2)
                     : region == 4 ? J.in_base + 5 * (SLOT / 2) : J.gb_base;
        const int row0 = u.pm * BM + wr * 64 + fr, col0 = (u.pn & 3) * BM + wc * 32 + 8 * fq;
#pragma unroll
        for (int ai = 0; ai < 2; ++ai)
#pragma unroll
            for (int m = 0; m < 4; ++m) {
                const int row = row0 + ai * HALF + m * 16;
                bf16_t* rowp = base + (size_t)row * DM + col0;
                f32x4 t0 = {1.f, 0.f, 1.f, 0.f}, t1 = {1.f, 0.f, 1.f, 0.f};
                if (region == 2 || region == 3) {
                    const float* tp = J.rope + ((size_t)(row & (SEQ - 1)) * 32 + 16 * (wc & 1) + 4 * fq) * 2;
                    t0 = *(const f32x4*)tp; t1 = *(const f32x4*)(tp + 4);
                }
#pragma unroll
                for (int bj = 0; bj < 2; ++bj) {
                    f32x4 v0 = acc[ai][bj][m][0], v1 = acc[ai][bj][m][1];
                    if (region < 2) {
#pragma unroll
                        for (int j = 0; j < 4; ++j) { v0[j] = gelu_tanh(v0[j]); v1[j] = gelu_tanh(v1[j]); }
                    } else if (region < 4) {
                        const float sc = region == 2 ? QSCALE : 1.0f;
                        f32x4 a, b;
                        a[0] = (v0[0] * t0[0] - v0[1] * t0[1]) * sc; a[1] = (v0[1] * t0[0] + v0[0] * t0[1]) * sc;
                        a[2] = (v0[2] * t0[2] - v0[3] * t0[3]) * sc; a[3] = (v0[3] * t0[2] + v0[2] * t0[3]) * sc;
                        b[0] = (v1[0] * t1[0] - v1[1] * t1[1]) * sc; b[1] = (v1[1] * t1[0] + v1[0] * t1[1]) * sc;
                        b[2] = (v1[2] * t1[2] - v1[3] * t1[3]) * sc; b[3] = (v1[3] * t1[2] + v1[2] * t1[3]) * sc;
                        v0 = a; v1 = b;
                    } else {
#pragma unroll
                        for (int j = 0; j < 4; ++j) { v0[j] = sigmoid_f(v0[j]); v1[j] = sigmoid_f(v1[j]); }
                    }
                    u32x4 w; w.x = cvt_pk_bf16(v0[0], v0[1]); w.y = cvt_pk_bf16(v0[2], v0[3]); w.z = cvt_pk_bf16(v1[0], v1[1]); w.w = cvt_pk_bf16(v1[2], v1[3]);
                    if (region == 3) {
                        const size_t ko = ((size_t)((row >> 13) * 8 + (u.pn & 3) * 2 + bj) * SEQ + (row & (SEQ - 1))) * 128 + wc * 32 + 8 * fq;
                        *(u32x4*)(base + ko) = w;
                    } else *(u32x4*)(rowp + bj * HALF) = w;
                }
            }
    } else if (mode == EPI_BF16 || mode == EPI_RELU2 || mode == EPI_BRA || mode == EPI_BRB || mode == EPI_VT) {
        const bool widem = (mode == EPI_BRA || mode == EPI_BRB || mode == EPI_VT);
        const int wcs = widem ? 64 : 32, bjs = widem ? 32 : HALF;
        const int row0 = u.pm * BM + wr * 64 + fr, col0 = u.pn * BM + wc * wcs + 8 * fq;
#pragma unroll
        for (int ai = 0; ai < 2; ++ai)
#pragma unroll
            for (int m = 0; m < 4; ++m) {
                const size_t off = (size_t)(row0 + ai * HALF + m * 16) * J.ldc + col0;
#pragma unroll
                for (int bj = 0; bj < 2; ++bj) {
                    f32x4 v0 = acc[ai][bj][m][0], v1 = acc[ai][bj][m][1];
                    if (mode == EPI_RELU2) {
#pragma unroll
                        for (int j = 0; j < 4; ++j) { const float a = fmaxf(v0[j], 0.f), b = fmaxf(v1[j], 0.f); v0[j] = a * a; v1[j] = b * b; }
                    } else if (mode == EPI_BRA || mode == EPI_BRB) {
                        const u32x4 g = *(const u32x4*)(J.o0 + off + bj * bjs);
                        v0[0] *= bf_lo(g.x); v0[1] *= bf_hi(g.x); v0[2] *= bf_lo(g.y); v0[3] *= bf_hi(g.y);
                        v1[0] *= bf_lo(g.z); v1[1] *= bf_hi(g.z); v1[2] *= bf_lo(g.w); v1[3] *= bf_hi(g.w);
                        if (mode == EPI_BRB) {
                            const u32x4 t = *(const u32x4*)(J.i0 + off + bj * bjs);
                            v0[0] += bf_lo(t.x); v0[1] += bf_hi(t.x); v0[2] += bf_lo(t.y); v0[3] += bf_hi(t.y);
                            v1[0] += bf_lo(t.z); v1[1] += bf_hi(t.z); v1[2] += bf_lo(t.w); v1[3] += bf_hi(t.w);
                        }
                    }
                    u32x4 w; w.x = cvt_pk_bf16(v0[0], v0[1]); w.y = cvt_pk_bf16(v0[2], v0[3]); w.z = cvt_pk_bf16(v1[0], v1[1]); w.w = cvt_pk_bf16(v1[2], v1[3]);
                    if (mode == EPI_VT) {
                        const int feat = row0 + ai * HALF + m * 16, tok = col0 + bj * bjs;
                        const size_t vo = ((((size_t)((tok >> 13) * 8 + (feat >> 7)) * 128 + ((tok & (SEQ - 1)) >> 6)) * 128 + (feat & 127)) * 64) + (tok & 63);
                        *(u32x4*)(J.o0 + vo) = w;
                    } else
                    *(u32x4*)(J.o0 + off + bj * bjs) = w;
                }
            }
    } else {
        const int row0 = u.pm * BM + wr * 64 + fr, col0 = u.pn * BM + wc * 64 + 8 * fq;
#pragma unroll
        for (int ai = 0; ai < 2; ++ai)
#pragma unroll
            for (int m = 0; m < 4; ++m) {
                const int row = row0 + ai * HALF + m * 16;
                const size_t off = (size_t)row * DM + col0;
                float s = 0.f;
#pragma unroll
                for (int bj = 0; bj < 2; ++bj) {
                    f32x4 v0 = acc[ai][bj][m][0], v1 = acc[ai][bj][m][1];
                    if (mode == EPI_GATE) {
                        const f32x4 b0 = *(const f32x4*)(J.bias + col0 + bj * 32), b1 = *(const f32x4*)(J.bias + col0 + bj * 32 + 4);
                        const u32x4 e = *(const u32x4*)(J.i0 + off + bj * 32);
                        v0[0] = bf_lo(e.x) * sigmoid_f(v0[0] + b0[0]); v0[1] = bf_hi(e.x) * sigmoid_f(v0[1] + b0[1]);
                        v0[2] = bf_lo(e.y) * sigmoid_f(v0[2] + b0[2]); v0[3] = bf_hi(e.y) * sigmoid_f(v0[3] + b0[3]);
                        v1[0] = bf_lo(e.z) * sigmoid_f(v1[0] + b1[0]); v1[1] = bf_hi(e.z) * sigmoid_f(v1[1] + b1[1]);
                        v1[2] = bf_lo(e.w) * sigmoid_f(v1[2] + b1[2]); v1[3] = bf_hi(e.w) * sigmoid_f(v1[3] + b1[3]);
                    }
                    u32x4 w; w.x = cvt_pk_bf16(v0[0], v0[1]); w.y = cvt_pk_bf16(v0[2], v0[3]); w.z = cvt_pk_bf16(v1[0], v1[1]); w.w = cvt_pk_bf16(v1[2], v1[3]);
                    *(u32x4*)((bf16_t*)J.fo + off + bj * 32) = w;
                    s += ((v0[0] * v0[0] + v0[1] * v0[1]) + (v0[2] * v0[2] + v0[3] * v0[3])) + ((v1[0] * v1[0] + v1[1] * v1[1]) + (v1[2] * v1[2] + v1[3] * v1[3]));
                }
                s += __shfl_xor(s, 16); s += __shfl_xor(s, 32);
                if (fq == 0) atomicAdd(J.ss + row, s);
            }
    }
}

DI void gemm_phase(LAS unsigned char* lds, const GemmJob& J, int G, int cidx) {
    const int tid = opaque_tid(), wid = __builtin_amdgcn_readfirstlane(tid >> 6), lane = tid & 63, wr = wid >> 2, wc = wid & 3, fr = lane & 15, fq = lane >> 4;
    const int K = J.K, nt = K / BK;
    const bool perm = true;
    const bool wide = (J.mode == EPI_BRA || J.mode == EPI_BRB || J.mode == EPI_RAW || J.mode == EPI_GATE || J.mode == EPI_VT);
    StaticOrder S; S.init(J.M, J.N, G, cidx);
    unsigned voffA[2], voffB[2];
#pragma unroll
    for (int i = 0; i < 2; ++i) { int R, C; stage_rc(tid * 16 + i * 8192, R, C); const int Rb = perm ? ((R & ~31) + perm32(R & 31)) : R;
        const int Rw = 64 * (R >> 5) + perm32(R & 31);
        voffA[i] = (unsigned)(R * K + C) * 2u; voffB[i] = (unsigned)((wide ? Rw : Rb) * K + C) * 2u; }
    const size_t kstep = (size_t)(BK * 2);
    const size_t hstep = (size_t)HALF * K * 2;
    const size_t tstep = 2 * hstep;
    const size_t hstepB = wide ? (size_t)32 * K * 2 : hstep;
    const unsigned ldsw = (unsigned)wid * 1024u;
    const int aoff = lds_byte(wr * 64 + fr, fq * 8), boff = lds_byte(wc * 32 + fr, fq * 8);
#define PG8_SA(b, h) (((b) * 2 + (h)) * HTB)
#define PG8_SB(b, h) ((4 + (b) * 2 + (h)) * HTB)
#define PG8_STAGE(bufoff, gbase, voff) do { _Pragma("unroll") for (int _i = 0; _i < 2; ++_i) \
        __builtin_amdgcn_global_load_lds((const unsigned*)((const char*)(gbase) + (voff)[_i]), (LAS unsigned*)(lds + (bufoff) + ldsw + _i * 8192), 16, 0, 0); } while (0)
#define PG8_LDA(dst, b, h) do { _Pragma("unroll") for (int m = 0; m < 4; ++m) _Pragma("unroll") for (int k = 0; k < 2; ++k) dst[m][k] = *(const LAS bf16x8*)(lds + PG8_SA(b, h) + aoff + m * 2048 + k * 1024); } while (0)
#define PG8_LDB(dst, b, h) do { _Pragma("unroll") for (int n = 0; n < 2; ++n) _Pragma("unroll") for (int k = 0; k < 2; ++k) dst[n][k] = *(const LAS bf16x8*)(lds + PG8_SB(b, h) + boff + n * 2048 + k * 1024); } while (0)
#define PG8_MMA(ai, bj, At, Bt) do { __builtin_amdgcn_s_setprio(1); _Pragma("unroll") for (int m = 0; m < 4; ++m) _Pragma("unroll") for (int n = 0; n < 2; ++n) _Pragma("unroll") for (int k = 0; k < 2; ++k) \
        acc[ai][bj][m][n] = __builtin_amdgcn_mfma_f32_16x16x32_bf16(Bt[n][k], At[m][k], acc[ai][bj][m][n], 0, 0, 0); __builtin_amdgcn_s_setprio(0); } while (0)
#define PG8_WAIT_V(n) asm volatile("s_waitcnt vmcnt(" #n ")" ::: "memory")
#define PG8_WAIT_L(n) asm volatile("s_waitcnt lgkmcnt(" #n ")" ::: "memory")
#define PG8_BAR __builtin_amdgcn_s_barrier()
#define PG8_SCHED __builtin_amdgcn_sched_barrier(0)
    Unit cur, nxt; int ui = 0;
    if (!S.next(0, cur)) return;
    f32x4 acc[2][2][4][2];
#pragma unroll
    for (int a = 0; a < 2; ++a)
#pragma unroll
        for (int b = 0; b < 2; ++b)
#pragma unroll
            for (int m = 0; m < 4; ++m)
#pragma unroll
                for (int n = 0; n < 2; ++n) acc[a][b][m][n] = (f32x4){0.f, 0.f, 0.f, 0.f};
    bf16x8 At[4][2], B0[2][2], B1[2][2];
    const char* cA = (const char*)J.A + (size_t)cur.pm * tstep; const char* cB = (const char*)J.Bt + (size_t)cur.pn * tstep;
    PG8_STAGE(PG8_SB(0, 0), cB, voffB); PG8_STAGE(PG8_SA(0, 0), cA, voffA); PG8_STAGE(PG8_SB(0, 1), cB + hstepB, voffB); PG8_STAGE(PG8_SA(0, 1), cA + hstep, voffA);
    if (wr == 1) PG8_BAR;
    PG8_WAIT_V(4); PG8_BAR;
    PG8_STAGE(PG8_SB(1, 0), cB + kstep, voffB); PG8_STAGE(PG8_SA(1, 0), cA + kstep, voffA); PG8_STAGE(PG8_SB(1, 1), cB + hstepB + kstep, voffB);
    PG8_WAIT_V(6); PG8_BAR;
    for (;;) {
        const bool has_next = S.next(ui + 1, nxt);
        const char* nA = has_next ? (const char*)J.A + (size_t)nxt.pm * tstep : cA; const char* nB = has_next ? (const char*)J.Bt + (size_t)nxt.pn * tstep : cB;
        for (int t = 0; t < nt; t += 2) {
            const bool last = (t == nt - 2);
            const char* a1 = cA + (size_t)(t + 1) * kstep;
            const char* a2 = last ? nA : cA + (size_t)(t + 2) * kstep; const char* b2 = last ? nB : cB + (size_t)(t + 2) * kstep;
            const char* a3 = a2 + kstep; const char* b3 = b2 + kstep;
            PG8_LDB(B0, 0, 0); PG8_SCHED; PG8_LDA(At, 0, 0); PG8_STAGE(PG8_SA(1, 1), a1 + hstep, voffA);
            PG8_WAIT_L(8); PG8_BAR; PG8_WAIT_L(0); PG8_MMA(0, 0, At, B0); PG8_BAR; PG8_SCHED;
            PG8_LDB(B1, 0, 1); PG8_STAGE(PG8_SB(0, 0), b2, voffB);
            PG8_BAR; PG8_WAIT_L(0); PG8_MMA(0, 1, At, B1); PG8_BAR;
            PG8_LDA(At, 0, 1); PG8_STAGE(PG8_SA(0, 0), a2, voffA);
            PG8_BAR; PG8_WAIT_L(0); PG8_MMA(1, 0, At, B0); PG8_BAR; PG8_SCHED;
            PG8_STAGE(PG8_SB(0, 1), b2 + hstepB, voffB);
            PG8_WAIT_V(6); PG8_BAR; PG8_MMA(1, 1, At, B1); PG8_BAR;
            PG8_LDB(B0, 1, 0); PG8_SCHED; PG8_LDA(At, 1, 0); PG8_STAGE(PG8_SA(0, 1), a2 + hstep, voffA);
            PG8_WAIT_L(8); PG8_BAR; PG8_WAIT_L(0); PG8_MMA(0, 0, At, B0); PG8_BAR; PG8_SCHED;
            PG8_LDB(B1, 1, 1); PG8_STAGE(PG8_SB(1, 0), b3, voffB);
            PG8_BAR; PG8_WAIT_L(0); PG8_MMA(0, 1, At, B1); PG8_BAR;
            PG8_LDA(At, 1, 1); PG8_STAGE(PG8_SA(1, 0), a3, voffA);
            PG8_BAR; PG8_WAIT_L(0); PG8_MMA(1, 0, At, B0); PG8_BAR; PG8_SCHED;
            PG8_STAGE(PG8_SB(1, 1), b3 + hstepB, voffB);
            PG8_WAIT_V(6); PG8_BAR; PG8_MMA(1, 1, At, B1); PG8_BAR;
        }
        epilogue(acc, cur, wr, wc, fr, fq, J);
        if (!has_next) break;
#pragma unroll
        for (int a = 0; a < 2; ++a)
#pragma unroll
            for (int b = 0; b < 2; ++b)
#pragma unroll
                for (int m = 0; m < 4; ++m)
#pragma unroll
                    for (int n = 0; n < 2; ++n) acc[a][b][m][n] = (f32x4){0.f, 0.f, 0.f, 0.f};
        cur = nxt; cA = nA; cB = nB; ++ui;
    }
    PG8_WAIT_V(0);
    if (wr == 0) PG8_BAR;
    PG8_BAR;
#undef PG8_SA
#undef PG8_SB
#undef PG8_STAGE
#undef PG8_LDA
#undef PG8_LDB
#undef PG8_MMA
#undef PG8_WAIT_V
#undef PG8_WAIT_L
#undef PG8_BAR
#undef PG8_SCHED
}

DI bf16_t* win_dstrow(int sc, bf16_t* win_t, bf16_t* wva_t) {
    if (sc < 2048) return win_t + (size_t)sc * DM;
    if (sc < 4096) { const int g = sc & ~63, d = sc & 63, p = ((d & 31) << 1) | (d >> 5); return win_t + (size_t)(g + p) * DM; }
    if (sc < 5120) return wva_t + (size_t)(sc - 4096) * DM;
    return win_t + (size_t)(sc - 1024) * DM;
}
struct TJob { const float* src; int Kdim, Ncols, tk, tn, mode; bf16_t* dst; bf16_t* dst2; };
DI TJob tjob(const Params& P, unsigned char* misc, int t) {
    TJob j; j.mode = 0; j.dst2 = nullptr;
    if (t < 1792) { j.src = P.in[3]; j.Kdim = 1024; j.Ncols = 7168; j.tk = t / 112; j.tn = t % 112; j.mode = 1; j.dst = (bf16_t*)(misc + OFF_WIN); j.dst2 = (bf16_t*)(misc + OFF_WVA); }
    else if (t < 2560) { const int q = t - 1792, w = q >> 8, tt = q & 255; j.src = w == 0 ? P.in[13] : w == 1 ? P.in[14] : P.in[15];
        j.dst = (bf16_t*)(misc + (w == 0 ? OFF_WA : w == 1 ? OFF_WB : OFF_WO)); j.Kdim = 1024; j.Ncols = 1024; j.tk = tt >> 4; j.tn = tt & 15; }
    else if (t < 3584) { const int q = t - 2560; j.src = P.in[18]; j.Kdim = 1024; j.Ncols = 4096; j.tk = q >> 6; j.tn = q & 63; j.dst = (bf16_t*)(misc + OFF_WF1); }
    else if (t < 4608) { const int q = t - 3584; j.src = P.in[19]; j.Kdim = 4096; j.Ncols = 1024; j.tk = q >> 4; j.tn = q & 15; j.dst = (bf16_t*)(misc + OFF_WF2); }
    else if (t < 4672) { const int q = t - 4608; j.src = P.in[21]; j.Kdim = 256; j.Ncols = 1024; j.tk = q >> 4; j.tn = q & 15; j.dst = (bf16_t*)(misc + OFF_WP); }
    else { const int q = t - 4672; j.src = P.in[22]; j.Kdim = 1024; j.Ncols = 1024; j.tk = q >> 4; j.tn = q & 15; j.dst = (bf16_t*)(misc + OFF_WG); }
    return j;
}
DI void tconv_load(const TJob& j, int tid, f32x4 (&v)[2]) {
    const int c4 = (tid & 15) * 4, r = tid >> 4;
#pragma unroll
    for (int i = 0; i < 2; ++i) v[i] = *(const f32x4*)(j.src + (size_t)(j.tk * 64 + r + 32 * i) * j.Ncols + j.tn * 64 + c4);
}
DI void tconv_finish(LAS float* tile, const TJob& j, int tid, const f32x4 (&v)[2]) {
    const int k0 = j.tk * 64, c0 = j.tn * 64;
    {
        const int c4 = (tid & 15) * 4, r = tid >> 4;
#pragma unroll
        for (int i = 0; i < 2; ++i) {
            const int rr = r + 32 * i;
            tile[(c4 + 0) * 65 + rr] = v[i][0]; tile[(c4 + 1) * 65 + rr] = v[i][1]; tile[(c4 + 2) * 65 + rr] = v[i][2]; tile[(c4 + 3) * 65 + rr] = v[i][3];
        }
    }
    __syncthreads();
    {
        const int cc = tid >> 3, r8 = (tid & 7) * 8;
        float f[8];
#pragma unroll
        for (int q = 0; q < 8; ++q) f[q] = tile[cc * 65 + r8 + q];
        u32x4 w; w.x = cvt_pk_bf16(f[0], f[1]); w.y = cvt_pk_bf16(f[2], f[3]); w.z = cvt_pk_bf16(f[4], f[5]); w.w = cvt_pk_bf16(f[6], f[7]);
        bf16_t* rowp = j.mode == 1 ? win_dstrow(c0 + cc, j.dst, j.dst2) : j.dst + (size_t)(c0 + cc) * j.Kdim;
        *(u32x4*)(rowp + k0 + r8) = w;
    }
}

DI void prologue(LAS unsigned char* lds, const Params& P, int G) {
    unsigned char* misc = P.ws + 7 * SLOT;
    const int tid = opaque_tid(), lane = tid & 63, wid = tid >> 6;
    {
        int t = blockIdx.x; int par = 0;
        TJob cur = tjob(P, misc, t); f32x4 v[2]; tconv_load(cur, tid, v);
        while (t < 4928) {
            const int tn_ = t + G; const bool hn = tn_ < 4928;
            TJob nx = cur; f32x4 vn[2] = {v[0], v[1]};
            if (hn) { nx = tjob(P, misc, tn_); tconv_load(nx, tid, vn); }
            tconv_finish((LAS float*)(lds + par * 16640), cur, tid, v);
            cur = nx; v[0] = vn[0]; v[1] = vn[1]; t = tn_; par ^= 1;
        }
        __syncthreads();
    }
    const size_t gtid = (size_t)blockIdx.x * 512 + tid, gthreads = (size_t)G * 512;
    {
        float* rope = (float*)(misc + OFF_ROPE);
        for (size_t i = gtid; i < (size_t)SEQ * 32; i += gthreads) {
            const int pos = (int)(i >> 5), f = (int)(i & 31);
            const float inv = 1.0f / powf(10000.0f, (float)(2 * f) / 64.0f);
            const float ang = (float)pos * inv;
            const double a = (double)ang; const double kq = __builtin_rint(a * 0.15915494309189535); const float rr = (float)(a - kq * 6.283185307179586);
            rope[2 * i] = cosf(rr); rope[2 * i + 1] = sinf(rr);
        }
    }
    { float* ss = (float*)(misc + OFF_SS); for (size_t i = gtid; i < (size_t)3 * MT; i += gthreads) ss[i] = 0.f; }
    {
        bf16_t* wsb = (bf16_t*)(misc + OFF_WS); const float* w = P.in[6];
        for (size_t i = gtid; i < (size_t)8 * 128 * 128; i += gthreads) {
            const int s = (int)(i & 127), t = (int)((i >> 7) & 127);
            const float v = ((s >> 6) <= (t >> 6)) ? w[i] : 0.f;
            wsb[i] = (bf16_t)(cvt_pk_bf16(v, 0.f) & 0xffffu);
        }
    }
    {
        const f32x4* p4 = (const f32x4*)P.in[1]; u32x2* pb = (u32x2*)(misc + OFF_PB);
        for (size_t i = gtid; i < (size_t)MT * PLED / 4; i += gthreads) { const f32x4 v = p4[i]; u32x2 w; w.x = cvt_pk_bf16(v[0], v[1]); w.y = cvt_pk_bf16(v[2], v[3]); pb[i] = w; }
    }
    {
        const float* x = P.in[0]; const float* g = P.in[2]; bf16_t* xn = (bf16_t*)(P.ws);
        f32x4 gv[4];
#pragma unroll
        for (int i = 0; i < 4; ++i) gv[i] = *(const f32x4*)(g + 256 * i + lane * 4);
        for (int row = blockIdx.x * 8 + wid; row < MT; row += G * 8) {
            f32x4 v[4]; float s = 0.f;
#pragma unroll
            for (int i = 0; i < 4; ++i) { v[i] = *(const f32x4*)(x + (size_t)row * DM + 256 * i + lane * 4); s += (v[i][0] * v[i][0] + v[i][1] * v[i][1]) + (v[i][2] * v[i][2] + v[i][3] * v[i][3]); }
            s = wave_sum(s);
            const float rs = rsqrtf(s * (1.0f / DM) + EPSV);
#pragma unroll
            for (int i = 0; i < 4; ++i) { u32x2 w; w.x = cvt_pk_bf16(v[i][0] * rs * gv[i][0], v[i][1] * rs * gv[i][1]); w.y = cvt_pk_bf16(v[i][2] * rs * gv[i][2], v[i][3] * rs * gv[i][3]);
                *(u32x2*)(xn + (size_t)row * DM + 256 * i + lane * 4) = w; }
        }
    }
}

DI void elementwise_phase(const Params& P, int which, int G) {
    unsigned char* misc = P.ws + 7 * SLOT;
    const int tid = opaque_tid(), lane = tid & 63, wid = tid >> 6;
    const float* ssb = (const float*)(misc + OFF_SS) + (size_t)which * MT;
    bf16_t* H = (bf16_t*)P.ws;
    const bf16_t* raw = which == 0 ? (const bf16_t*)(P.ws + 2 * SLOT) : which == 1 ? (const bf16_t*)P.out : (const bf16_t*)(P.ws + 4 * SLOT);
    const float* g1 = which == 0 ? P.in[16] : which == 1 ? P.in[20] : P.in[24];
    bf16_t* dstb = which == 0 ? (bf16_t*)P.out : (bf16_t*)(P.ws + 2 * SLOT);
    f32x4 gv[4], g2[4];
#pragma unroll
    for (int i = 0; i < 4; ++i) { const int col = 512 * (i >> 1) + lane * 8 + 4 * (i & 1); gv[i] = *(const f32x4*)(g1 + col); g2[i] = which == 0 ? *(const f32x4*)(P.in[17] + col) : (f32x4){1.f, 1.f, 1.f, 1.f}; }
    for (int row = blockIdx.x * 8 + wid; row < MT; row += G * 8) {
        const float rs = rsqrtf(ssb[row] * (1.0f / DM) + EPSV);
        f32x4 h[4]; float s = 0.f;
#pragma unroll
        for (int c = 0; c < 2; ++c) {
            const size_t o = (size_t)row * DM + 512 * c + lane * 8;
            f32x4 b0, b1;
            if (which == 0) { b0 = *(const f32x4*)(P.in[0] + o); b1 = *(const f32x4*)(P.in[0] + o + 4); }
            else { const u32x4 hw = *(const u32x4*)(H + o); b0 = (f32x4){bf_lo(hw.x), bf_hi(hw.x), bf_lo(hw.y), bf_hi(hw.y)}; b1 = (f32x4){bf_lo(hw.z), bf_hi(hw.z), bf_lo(hw.w), bf_hi(hw.w)}; }
            const u32x4 rw = *(const u32x4*)(raw + o);
            const f32x4 r0 = {bf_lo(rw.x), bf_hi(rw.x), bf_lo(rw.y), bf_hi(rw.y)}, r1 = {bf_lo(rw.z), bf_hi(rw.z), bf_lo(rw.w), bf_hi(rw.w)};
            h[2 * c] = b0 + r0 * rs * gv[2 * c]; h[2 * c + 1] = b1 + r1 * rs * gv[2 * c + 1];
        }
#pragma unroll
        for (int i = 0; i < 4; ++i) s += (h[i][0] * h[i][0] + h[i][1] * h[i][1]) + (h[i][2] * h[i][2] + h[i][3] * h[i][3]);
        float rs2 = 1.0f;
        if (which == 0) { s = wave_sum(s); rs2 = rsqrtf(s * (1.0f / DM) + EPSV); }
#pragma unroll
        for (int c = 0; c < 2; ++c) {
            const size_t o = (size_t)row * DM + 512 * c + lane * 8;
            const f32x4 h0 = h[2 * c], h1 = h[2 * c + 1];
            if (which == 2) { *(f32x4*)(P.out + o) = h0; *(f32x4*)(P.out + o + 4) = h1; }
            else {
                u32x4 hw; hw.x = cvt_pk_bf16(h0[0], h0[1]); hw.y = cvt_pk_bf16(h0[2], h0[3]); hw.z = cvt_pk_bf16(h1[0], h1[1]); hw.w = cvt_pk_bf16(h1[2], h1[3]);
                *(u32x4*)(H + o) = hw;
                if (which == 0) { const f32x4 a0 = h0 * rs2 * g2[2 * c], a1 = h1 * rs2 * g2[2 * c + 1];
                    u32x4 w; w.x = cvt_pk_bf16(a0[0], a0[1]); w.y = cvt_pk_bf16(a0[2], a0[3]); w.z = cvt_pk_bf16(a1[0], a1[1]); w.w = cvt_pk_bf16(a1[2], a1[3]); *(u32x4*)(dstb + o) = w; }
                else *(u32x4*)(dstb + o) = hw;
            }
        }
    }
}

typedef short s16x4 __attribute__((ext_vector_type(4)));
DI void gmlp_phase(LAS unsigned char* lds, const Params& P, int G) {
    unsigned char* misc = P.ws + 7 * SLOT;
    const int tid = opaque_tid(), lane = tid & 63, wid = tid >> 6, fr = lane & 15, fq = lane >> 4;
    bf16_t* U = (bf16_t*)(P.ws + 1 * SLOT); const bf16_t* V = (const bf16_t*)(P.ws + 2 * SLOT);
    const bf16_t* WS = (const bf16_t*)(misc + OFF_WS);
    const float* lng = P.in[4]; const float* lnb = P.in[5]; const float* bs = P.in[7];
    LAS float* st = (LAS float*)lds;
    LAS unsigned char* vs = lds + 1024;
    constexpr int PV = 272;
    const int trq = fr >> 2, trp = fr & 3;
    for (int blk = blockIdx.x; blk < MT / 128; blk += G) {
        const size_t tok0 = (size_t)blk * 128;
        for (int r4 = 0; r4 < 4; ++r4) {
            float sm[4], sq[4];
#pragma unroll
            for (int e = 0; e < 4; ++e) {
                const bf16_t* vp = V + (tok0 + wid * 16 + r4 * 4 + e) * DM;
                const u32x4 a = *(const u32x4*)(vp + lane * 8), b2 = *(const u32x4*)(vp + 512 + lane * 8);
                float s0 = 0.f, q0 = 0.f;
#pragma unroll
                for (int j = 0; j < 4; ++j) { const float x0 = bf_lo(a[j]), x1 = bf_hi(a[j]), y0 = bf_lo(b2[j]), y1 = bf_hi(b2[j]); s0 += (x0 + x1) + (y0 + y1); q0 += (x0 * x0 + x1 * x1) + (y0 * y0 + y1 * y1); }
                sm[e] = s0; sq[e] = q0;
            }
#pragma unroll
            for (int o = 32; o >= 1; o >>= 1) {
#pragma unroll
                for (int e = 0; e < 4; ++e) { sm[e] += __shfl_xor(sm[e], o); sq[e] += __shfl_xor(sq[e], o); }
            }
            if (lane < 4) {
                const float s0 = lane == 0 ? sm[0] : lane == 1 ? sm[1] : lane == 2 ? sm[2] : sm[3];
                const float q0 = lane == 0 ? sq[0] : lane == 1 ? sq[1] : lane == 2 ? sq[2] : sq[3];
                const float mu = s0 * (1.0f / DM); const float var = fmaxf(q0 * (1.0f / DM) - mu * mu, 0.f);
                const int row = wid * 16 + r4 * 4 + lane; st[row * 2] = mu; st[row * 2 + 1] = rsqrtf(var + EPSV);
            }
        }
        u32x4 vreg[4];
#pragma unroll
        for (int i = 0; i < 4; ++i) { const int id = tid + 512 * i; vreg[i] = *(const u32x4*)(V + (tok0 + (id >> 4)) * DM + (id & 15) * 8); }
        u32x4 unext[4];
#pragma unroll
        for (int np = 0; np < 4; ++np) unext[np] = *(const u32x4*)(U + (tok0 + 16 * wid + fr) * DM + 32 * np + 8 * fq);
        __syncthreads();
        for (int g = 0; g < 8; ++g) {
#pragma unroll
            for (int i = 0; i < 4; ++i) {
                const int id = tid + 512 * i, sr = id >> 4, cc = (id & 15) * 8;
                const u32x4 v = vreg[i];
                const float mu = st[2 * sr], rs = st[2 * sr + 1];
                const f32x4 ga = *(const f32x4*)(lng + g * 128 + cc), gb = *(const f32x4*)(lng + g * 128 + cc + 4);
                const f32x4 ba = *(const f32x4*)(lnb + g * 128 + cc), bb = *(const f32x4*)(lnb + g * 128 + cc + 4);
                u32x4 w;
                w.x = cvt_pk_bf16((bf_lo(v.x) - mu) * rs * ga[0] + ba[0], (bf_hi(v.x) - mu) * rs * ga[1] + ba[1]);
                w.y = cvt_pk_bf16((bf_lo(v.y) - mu) * rs * ga[2] + ba[2], (bf_hi(v.y) - mu) * rs * ga[3] + ba[3]);
                w.z = cvt_pk_bf16((bf_lo(v.z) - mu) * rs * gb[0] + bb[0], (bf_hi(v.z) - mu) * rs * gb[1] + bb[1]);
                w.w = cvt_pk_bf16((bf_lo(v.w) - mu) * rs * gb[2] + bb[2], (bf_hi(v.w) - mu) * rs * gb[3] + bb[3]);
                *(LAS u32x4*)(vs + sr * PV + cc * 2) = w;
            }
            if (g < 7) {
#pragma unroll
                for (int i = 0; i < 4; ++i) { const int id = tid + 512 * i; vreg[i] = *(const u32x4*)(V + (tok0 + (id >> 4)) * DM + (g + 1) * 128 + (id & 15) * 8); }
            }
            const int t = 16 * wid + fr;
            bf16x8 wa[4];
#pragma unroll
            for (int kk = 0; kk < 4; ++kk) wa[kk] = *(const bf16x8*)(WS + (size_t)(g * 128 + t) * 128 + 32 * kk + 8 * fq);
            u32x4 uu[4];
#pragma unroll
            for (int np = 0; np < 4; ++np) uu[np] = unext[np];
            if (g < 7) {
#pragma unroll
                for (int np = 0; np < 4; ++np) unext[np] = *(const u32x4*)(U + (tok0 + t) * DM + (g + 1) * 128 + 32 * np + 8 * fq);
            }
            const float bsv = bs[g * 128 + t];
            __syncthreads();
            f32x4 acc[8];
#pragma unroll
            for (int n = 0; n < 8; ++n) acc[n] = (f32x4){0.f, 0.f, 0.f, 0.f};
#pragma unroll
            for (int kk = 0; kk < 4; ++kk) {
#pragma unroll
                for (int n = 0; n < 8; ++n) {
                    LAS unsigned char* ap = vs + (32 * kk + 8 * fq + trq) * PV + 64 * (n >> 1) + 16 * trp + 8 * (n & 1);
                    const s16x4 lo = __builtin_amdgcn_ds_read_tr16_b64_v4i16((LAS s16x4*)ap);
                    const s16x4 hi = __builtin_amdgcn_ds_read_tr16_b64_v4i16((LAS s16x4*)(ap + 4 * PV));
                    const bf16x8 bfr = __builtin_shufflevector(lo, hi, 0, 1, 2, 3, 4, 5, 6, 7);
                    acc[n] = __builtin_amdgcn_mfma_f32_16x16x32_bf16(bfr, wa[kk], acc[n], 0, 0, 0);
                }
            }
#pragma unroll
            for (int np = 0; np < 4; ++np) {
                bf16_t* up = U + (tok0 + t) * DM + g * 128 + 32 * np + 8 * fq;
                const f32x4 a0 = acc[2 * np], a1 = acc[2 * np + 1]; const u32x4 u4 = uu[np];
                u32x4 w;
                w.x = cvt_pk_bf16(bf_lo(u4.x) * (a0[0] + bsv), bf_hi(u4.x) * (a0[1] + bsv)); w.y = cvt_pk_bf16(bf_lo(u4.y) * (a0[2] + bsv), bf_hi(u4.y) * (a0[3] + bsv));
                w.z = cvt_pk_bf16(bf_lo(u4.z) * (a1[0] + bsv), bf_hi(u4.z) * (a1[1] + bsv)); w.w = cvt_pk_bf16(bf_lo(u4.w) * (a1[2] + bsv), bf_hi(u4.w) * (a1[3] + bsv));
                *(u32x4*)up = w;
            }
            __syncthreads();
        }
    }
}

constexpr int ATT_KBUF = 16384, ATT_KCOMP = 8192, ATT_VBASE = 4 * ATT_KBUF, ATT_VBUF = 16384, ATT_XOFF = 0;
DI bf16x8 pack8(const f32x16& s, int b) {
    u32x4 p; p.x = cvt_pk_bf16(s[b + 0], s[b + 1]); p.y = cvt_pk_bf16(s[b + 2], s[b + 3]); p.z = cvt_pk_bf16(s[b + 4], s[b + 5]); p.w = cvt_pk_bf16(s[b + 6], s[b + 7]);
    return __builtin_bit_cast(bf16x8, p);
}
DI bf16x8 att_kfrag(LAS const unsigned char* Kb, int rowoff, int kk, int yb) { return *(LAS const bf16x8*)(Kb + rowoff + ((32 * kk) ^ yb)); }
DI bf16x8 att_vfrag(LAS const unsigned char* Vb, int d, int rowoff, int ks, int yb) { return *(LAS const bf16x8*)(Vb + d * 4096 + rowoff + ((32 * ks) ^ yb)); }
DI float att_rowmax1(const f32x16& S) {
    float mx = fmaxf(S[0], S[1]);
#pragma unroll
    for (int i = 2; i < 16; i += 2) mx = fmaxf(fmaxf(mx, S[i]), S[i + 1]);
    return xhalf_max(mx);
}
template <bool HAS_NEXT>
DI void att_half(f32x16& C, f32x16& N, f32x16 (&o)[4], const bf16x8 (&qf)[4], f32x16& negm, float& lrun, float& cmx,
                 LAS const unsigned char* Kn, LAS const unsigned char* Vb, int ks0, int kro, int kyb, int vro, int vyb) {
    if (__builtin_amdgcn_ballot_w64(cmx > 6.0f) != 0ull) {
        const float dlt = fmaxf(cmx, 0.f); const float sc = fast_exp2(-dlt); lrun *= sc;
#pragma unroll
        for (int i = 0; i < 16; ++i) { C[i] -= dlt; negm[i] -= dlt; }
#pragma unroll
        for (int d = 0; d < 4; ++d)
#pragma unroll
            for (int i = 0; i < 16; ++i) o[d][i] *= sc;
    }
    float ps = 0.f;
    bf16x8 vf[4];
    if (HAS_NEXT) {
        bf16x8 kf[2];
        kf[0] = att_kfrag(Kn, kro, 0, kyb);
#pragma unroll
        for (int kk = 0; kk < 4; ++kk) {
            if (kk < 3) kf[(kk + 1) & 1] = att_kfrag(Kn, kro, kk + 1, kyb);
            if (kk == 3) {
#pragma unroll
                for (int d = 0; d < 4; ++d) vf[d] = att_vfrag(Vb, d, vro, ks0, vyb);
            }
            N = __builtin_amdgcn_mfma_f32_32x32x16_bf16(kf[kk & 1], qf[kk], kk == 0 ? negm : N, 0, 0, 0);
#pragma unroll
            for (int i = 4 * kk; i < 4 * kk + 4; ++i) { C[i] = fast_exp2(C[i]); ps += C[i]; }
            __builtin_amdgcn_sched_barrier(0);
        }
    } else {
#pragma unroll
        for (int d = 0; d < 4; ++d) vf[d] = att_vfrag(Vb, d, vro, ks0, vyb);
#pragma unroll
        for (int i = 0; i < 16; ++i) { C[i] = fast_exp2(C[i]); ps += C[i]; }
    }
    lrun += ps;
    bf16x8 pf[2]; pf[0] = pack8(C, 0); pf[1] = pack8(C, 8);
#pragma unroll
    for (int d = 0; d < 4; ++d) o[d] = __builtin_amdgcn_mfma_f32_32x32x16_bf16(vf[d], pf[0], o[d], 0, 0, 0);
    __builtin_amdgcn_sched_barrier(0);
    bf16x8 vg[4];
#pragma unroll
    for (int d = 0; d < 4; ++d) vg[d] = att_vfrag(Vb, d, vro, ks0 + 1, vyb);
    if (HAS_NEXT) {
        float pm = fmaxf(N[0], N[1]);
#pragma unroll
        for (int i = 2; i < 16; i += 2) pm = fmaxf(fmaxf(pm, N[i]), N[i + 1]);
        cmx = xhalf_max(pm);
    }
#pragma unroll
    for (int d = 0; d < 4; ++d) o[d] = __builtin_amdgcn_mfma_f32_32x32x16_bf16(vg[d], pf[1], o[d], 0, 0, 0);
    __builtin_amdgcn_sched_barrier(0);
}
#define ATT_DMA_K(KT, BUF) do { _Pragma("unroll") for (int i = 0; i < 2; ++i) \
    __builtin_amdgcn_global_load_lds((const unsigned*)(kgp[i] + (size_t)(KT) * 64 * 128), (LAS unsigned*)(lds + (BUF) * ATT_KBUF + (wid * 2 + i) * 1024), 16, 0, 0); } while (0)
#define ATT_DMA_V(KT, BUF) do { _Pragma("unroll") for (int i = 0; i < 2; ++i) \
    __builtin_amdgcn_global_load_lds((const unsigned*)(vgp[i] + (size_t)(KT) * 8192), (LAS unsigned*)(lds + ATT_VBASE + (BUF) * ATT_VBUF + (wid * 2 + i) * 1024), 16, 0, 0); } while (0)

DI void att_tile_id(int idx, int G, int& b, int& h, int& qt) {
    const int u = blockIdx.x + (idx >> 1) * G;
    const int k = u / 256, w = u % 256, bh = k * 8 + (w & 7), j = w >> 3;
    b = bh >> 3; h = bh & 7; qt = (idx & 1) ? j : 63 - j;
}
DI void attn_phase(LAS unsigned char* lds, const Params& P, int G) {
    const bf16_t* Qg = (const bf16_t*)(P.ws + 3 * SLOT); const bf16_t* Kg = (const bf16_t*)(P.ws + 4 * SLOT); const bf16_t* Vtg = (const bf16_t*)(P.ws + 5 * SLOT);
    bf16_t* Og = (bf16_t*)(P.ws + 3 * SLOT);
    const float* subg = P.in[12];
    float d1 = 0.f, d2 = 0.f;
    for (int i = 0; i < 64; ++i) { d1 += P.in[8][i] * P.in[9][i]; d2 += P.in[10][i] * P.in[11][i]; }
    const float lam = expf(d1) - expf(d2) + 0.2f;
    const int tid = opaque_tid(), lane = tid & 63, wid = __builtin_amdgcn_readfirstlane(tid >> 6);
    const int comp = wid & 1, rg = wid >> 1, r = lane & 31, h2 = lane >> 5;
    const int pr = (r & 19) | ((r & 4) << 1) | ((r & 8) >> 1);
    const int kro = pr * 128, kyb = 16 * (h2 ^ ((pr >> 1) & 7)), vro = r * 128, vyb = 16 * (h2 ^ ((r >> 1) & 7));
    int ntiles = 0; for (int u = blockIdx.x; u < 2048; u += G) ntiles += 2;
#define ATT_BARV(N) do { asm volatile("s_waitcnt vmcnt(" #N ") lgkmcnt(0)" ::: "memory"); __builtin_amdgcn_s_barrier(); asm volatile("" ::: "memory"); } while (0)
#define ATT_BARL() do { asm volatile("s_waitcnt lgkmcnt(0)" ::: "memory"); __builtin_amdgcn_s_barrier(); asm volatile("" ::: "memory"); } while (0)
#define ATT_SETUP(B_, H_, QT_, KGP, VGP, QF) do { \
    _Pragma("unroll") for (int i = 0; i < 2; ++i) { \
        const int j = wid * 2 + i; \
        const int krow = (j & 7) * 8 + (lane >> 3), kc = (lane & 7) ^ ((krow >> 1) & 7); \
        KGP[i] = Kg + ((size_t)((B_) * 8 + (H_)) * SEQ + krow) * 128 + (j >> 3) * 64 + kc * 8; \
        const int d = j * 8 + (lane >> 3), vc = (lane & 7) ^ ((d >> 1) & 7); \
        VGP[i] = Vtg + (size_t)((B_) * 8 + (H_)) * 128 * 8192 + d * 64 + vc * 8; } \
    const bf16_t* qp = Qg + ((size_t)(B_) * SEQ + (QT_) * 128 + rg * 32 + r) * DM + (H_) * 128 + comp * 64 + 8 * h2; \
    _Pragma("unroll") for (int kk = 0; kk < 4; ++kk) QF[kk] = *(const bf16x8*)(qp + 16 * kk); } while (0)
    if (ntiles == 0) return;
    int b, h, qt; att_tile_id(0, G, b, h, qt);
    const bf16_t* kgp[2]; const bf16_t* vgp[2]; bf16x8 qf[4];
    ATT_SETUP(b, h, qt, kgp, vgp, qf);
    ATT_DMA_K(0, 0); ATT_DMA_K(1, 1); if (qt > 0) ATT_DMA_K(2, 2);
    for (int idx = 0; idx < ntiles; ++idx) {
        const int q0 = qt * 128 + rg * 32;
        const int nkt = 2 * qt + 2, nkt_w = 2 * qt + (rg >> 1) + 1;
        const size_t tokbase = (size_t)b * SEQ;
        ATT_DMA_V(0, 0); ATT_DMA_V(1, 1);
        ATT_BARV(2);
        f32x16 o[4];
#pragma unroll
        for (int d = 0; d < 4; ++d)
#pragma unroll
            for (int i = 0; i < 16; ++i) o[d][i] = 0.f;
        float lrun = 0.f;
        f32x16 sA, sB, negm; float cmx;
        {
            LAS const unsigned char* Kb0 = lds + comp * ATT_KCOMP;
            f32x16 z;
#pragma unroll
            for (int i = 0; i < 16; ++i) z[i] = 0.f;
            sA = z;
#pragma unroll
            for (int kk = 0; kk < 4; ++kk) sA = __builtin_amdgcn_mfma_f32_32x32x16_bf16(att_kfrag(Kb0, kro, kk, kyb), qf[kk], sA, 0, 0, 0);
            const float m0 = att_rowmax1(sA);
#pragma unroll
            for (int i = 0; i < 16; ++i) { sA[i] -= m0; negm[i] = -m0; }
            cmx = 0.f;
            sB = z;
        }
        int vb_cur = 0, vb_fill = 2;
        for (int kt = 0; kt < nkt - 1; ++kt) {
            const bool dk = (kt + 3 < nkt), dv = (kt + 2 < nkt);
            if (dk) ATT_DMA_K(kt + 3, (kt + 3) & 3);
            LAS const unsigned char* Vb = lds + ATT_VBASE + vb_cur * ATT_VBUF;
            att_half<true>(sA, sB, o, qf, negm, lrun, cmx, lds + (kt & 3) * ATT_KBUF + comp * ATT_KCOMP + 4096, Vb, 0, kro, kyb, vro, vyb);
            if (dv) ATT_DMA_V(kt + 2, vb_fill);
            att_half<true>(sB, sA, o, qf, negm, lrun, cmx, lds + ((kt + 1) & 3) * ATT_KBUF + comp * ATT_KCOMP, Vb, 2, kro, kyb, vro, vyb);
            vb_cur = (vb_cur == 2) ? 0 : vb_cur + 1; vb_fill = (vb_fill == 2) ? 0 : vb_fill + 1;
            if (dk) ATT_BARV(4); else if (dv) ATT_BARV(2); else ATT_BARV(0);
        }
        if (nkt_w == nkt) {
            LAS const unsigned char* Vb = lds + ATT_VBASE + vb_cur * ATT_VBUF;
            att_half<true>(sA, sB, o, qf, negm, lrun, cmx, lds + ((nkt - 1) & 3) * ATT_KBUF + comp * ATT_KCOMP + 4096, Vb, 0, kro, kyb, vro, vyb);
            att_half<false>(sB, sA, o, qf, negm, lrun, cmx, lds + (nkt & 3) * ATT_KBUF + comp * ATT_KCOMP, Vb, 2, kro, kyb, vro, vyb);
        }
        ATT_BARV(0);
        int nb = b, nh = h, nqt = qt; const bool has_next = idx + 1 < ntiles;
        const bf16_t* kgn[2] = {kgp[0], kgp[1]}; const bf16_t* vgn[2] = {vgp[0], vgp[1]}; bf16x8 qn[4] = {qf[0], qf[1], qf[2], qf[3]};
        if (has_next) {
            att_tile_id(idx + 1, G, nb, nh, nqt);
            ATT_SETUP(nb, nh, nqt, kgn, vgn, qn);
            { const bf16_t* const* kgp_s = kgn; (void)kgp_s; }
#define kgp kgn
            ATT_DMA_K(0, 0); ATT_DMA_K(1, 1); if (nqt > 0) ATT_DMA_K(2, 2);
#undef kgp
        }
        const float ltot = lrun + __shfl_xor(lrun, 32);
        const float inv = 1.0f / ltot;
        LAS float* xs = (LAS float*)(lds + 65536) + rg * 4096;
        if (comp == 1) {
#pragma unroll
            for (int d = 0; d < 4; ++d)
#pragma unroll
                for (int i = 0; i < 16; ++i) xs[(d * 16 + i) * 64 + lane] = o[d][i] * inv;
        }
        ATT_BARL();
        if (comp == 0) {
            float ssq = 0.f;
#pragma unroll
            for (int d = 0; d < 4; ++d)
#pragma unroll
                for (int i = 0; i < 16; ++i) { const float v = o[d][i] * inv - lam * xs[(d * 16 + i) * 64 + lane]; o[d][i] = v; ssq += v * v; }
            ssq += __shfl_xor(ssq, 32);
            const float rs = rsqrtf(ssq * (1.0f / 128.0f) + EPSV) * 0.8f;
            bf16_t* op = Og + (tokbase + q0 + r) * DM + h * 128;
#pragma unroll
            for (int d = 0; d < 4; ++d)
#pragma unroll
                for (int k2 = 0; k2 < 2; ++k2) {
                    u32x2 wa, wb;
                    { const int g4 = 2 * k2, dd = 32 * d + 8 * g4 + 4 * h2; const f32x4 gg = *(const f32x4*)(subg + dd);
                      wa.x = cvt_pk_bf16(o[d][4 * g4 + 0] * rs * gg[0], o[d][4 * g4 + 1] * rs * gg[1]); wa.y = cvt_pk_bf16(o[d][4 * g4 + 2] * rs * gg[2], o[d][4 * g4 + 3] * rs * gg[3]); }
                    { const int g4 = 2 * k2 + 1, dd = 32 * d + 8 * g4 + 4 * h2; const f32x4 gg = *(const f32x4*)(subg + dd);
                      wb.x = cvt_pk_bf16(o[d][4 * g4 + 0] * rs * gg[0], o[d][4 * g4 + 1] * rs * gg[1]); wb.y = cvt_pk_bf16(o[d][4 * g4 + 2] * rs * gg[2], o[d][4 * g4 + 3] * rs * gg[3]); }
                    const auto sx = __builtin_amdgcn_permlane32_swap(wa.x, wb.x, false, false);
                    const auto sy = __builtin_amdgcn_permlane32_swap(wa.y, wb.y, false, false);
                    u32x4 w; w.x = sx[0]; w.y = sy[0]; w.z = sx[1]; w.w = sy[1];
                    *(u32x4*)(op + 32 * d + 16 * k2 + 8 * h2) = w;
                }
        }
        ATT_BARL();
        b = nb; h = nh; qt = nqt;
#pragma unroll
        for (int i = 0; i < 2; ++i) { kgp[i] = kgn[i]; vgp[i] = vgn[i]; }
#pragma unroll
        for (int kk = 0; kk < 4; ++kk) qf[kk] = qn[kk];
    }
    asm volatile("s_waitcnt vmcnt(0)" ::: "memory");
#undef ATT_BARV
#undef ATT_BARL
#undef ATT_SETUP
}

#define XB_TMO      128
#define XB_XCNT(j)  (256  + 64 * (j))
#define XB_XSUB(j)  (1280 + 64 * (j))
#define XB_XGEN(j)  (2304 + 64 * (j))
#define XB_TOP      3328
#define XB_TOPGEN   3392
#define XCD_BAR_WORDS 3456
#define XB_SPIN_CAP (1u << 22)
DI unsigned xb_ld(unsigned* p)              { return __hip_atomic_load(p, __ATOMIC_RELAXED, __HIP_MEMORY_SCOPE_AGENT); }
DI unsigned xb_add(unsigned* p, unsigned v) { return __hip_atomic_fetch_add(p, v, __ATOMIC_RELAXED, __HIP_MEMORY_SCOPE_AGENT); }
DI unsigned xb_xcc_id() { return (unsigned)__builtin_amdgcn_s_getreg((3 << 11) | 20) & 0xFu; }
#define XB_SPIN(cond, bar) do { unsigned _sp = 0; while (cond) { __builtin_amdgcn_s_sleep(1); \
    if ((++_sp & 255u) == 0u) { if (xb_ld(&(bar)[XB_TMO])) break; if (_sp > XB_SPIN_CAP) { atomicAdd(&(bar)[XB_TMO], 1u); break; } } } } while (0)
struct XcdBarrier { unsigned* bar; unsigned x; volatile LAS unsigned* st; };
DI XcdBarrier xcd_barrier_post(unsigned* bar, volatile LAS unsigned* st) {
    XcdBarrier b; b.bar = bar; b.x = xb_xcc_id(); b.st = st;
    if (threadIdx.x == 0) (void)xb_add(&bar[XB_XCNT(b.x)], 1u);
    return b;
}
DI void xcd_barrier_complete(unsigned* bar, unsigned x, unsigned& nloc, unsigned& nx) {
    const unsigned G = gridDim.x * gridDim.y * gridDim.z;
    unsigned sum, cnt, mine, sp = 0u;
    for (;;) {
        sum = 0u; cnt = 0u; mine = 0u;
#pragma unroll
        for (unsigned j = 0; j < 16; ++j) { const unsigned c = xb_ld(&bar[XB_XCNT(j)]); sum += c; cnt += (c > 0u) ? 1u : 0u; mine = (j == x) ? c : mine; }
        if (sum == G) break;
        __builtin_amdgcn_s_sleep(1);
        if ((++sp & 255u) == 0u) { if (xb_ld(&bar[XB_TMO])) break; if (sp > XB_SPIN_CAP) { atomicAdd(&bar[XB_TMO], 1u); break; } }
    }
    nloc = mine > 0u ? mine : 1u; nx = cnt > 0u ? cnt : 1u;
}
DI void xcd_barrier(const XcdBarrier& b) {
    asm volatile("s_waitcnt vmcnt(0)" ::: "memory");
    __syncthreads();
    if (threadIdx.x == 0) {
        unsigned* bar = b.bar;
        __builtin_amdgcn_s_waitcnt(0);
        unsigned nloc = b.st[0], nx = b.st[1];
        if (nloc == 0u) { xcd_barrier_complete(bar, b.x, nloc, nx); b.st[0] = nloc; b.st[1] = nx; }
        const unsigned old = xb_add(&bar[XB_XSUB(b.x)], 1u);
        const unsigned gen = old / nloc;
        if (old + 1u == (gen + 1u) * nloc) {
            __builtin_amdgcn_fence(__ATOMIC_RELEASE, "agent");
            asm volatile("s_waitcnt vmcnt(0)" ::: "memory");
            const unsigned og = xb_add(&bar[XB_TOP], 1u);
            const unsigned tg = og / nx;
            if (og + 1u == (tg + 1u) * nx) xb_add(&bar[XB_TOPGEN], 1u);
            else XB_SPIN(xb_ld(&bar[XB_TOPGEN]) == tg, bar);
            __builtin_amdgcn_fence(__ATOMIC_ACQUIRE, "agent");
            xb_add(&bar[XB_XGEN(b.x)], 1u);
            asm volatile("s_waitcnt vmcnt(0)" ::: "memory");
        } else {
            XB_SPIN(xb_ld(&bar[XB_XGEN(b.x)]) == gen, bar);
            __builtin_amdgcn_fence(__ATOMIC_ACQUIRE, "agent");
            asm volatile("s_waitcnt vmcnt(0)" ::: "memory");
        }
    }
    __syncthreads();
}

DI GemmJob make_job(const Params& P, int ph, int g) {
    unsigned char* ws = P.ws; unsigned char* misc = ws + 7 * SLOT;
    GemmJob J{};
    J.ldc = DM; J.rope = (const float*)(misc + OFF_ROPE);
    if (ph == 1 && g == 0) { J.A = (const bf16_t*)ws; J.Bt = (const bf16_t*)(misc + OFF_WIN); J.M = MT; J.N = 6144; J.K = DM; J.mode = EPI_IN; J.in_base = (bf16_t*)(ws + SLOT); J.gb_base = (bf16_t*)P.out; }
    else if (ph == 1) { J.A = (const bf16_t*)(misc + OFF_WVA); J.Bt = (const bf16_t*)ws; J.M = 1024; J.N = MT; J.K = DM; J.mode = EPI_VT; J.o0 = (bf16_t*)(ws + 5 * SLOT); J.ldc = MT; }
    else if (ph == 3 && g == 0) { J.A = (const bf16_t*)(ws + SLOT); J.Bt = (const bf16_t*)(misc + OFF_WA); J.M = MT; J.N = DM; J.K = DM; J.mode = EPI_BRA; J.o0 = (bf16_t*)(ws + 6 * SLOT); }
    else if (ph == 3) { J.A = (const bf16_t*)(ws + 3 * SLOT); J.Bt = (const bf16_t*)(misc + OFF_WB); J.M = MT; J.N = DM; J.K = DM; J.mode = EPI_BRB; J.o0 = (bf16_t*)P.out; J.i0 = (const bf16_t*)(ws + 6 * SLOT); }
    else if (ph == 4) { J.A = (const bf16_t*)P.out; J.Bt = (const bf16_t*)(misc + OFF_WO); J.M = MT; J.N = DM; J.K = DM; J.mode = EPI_RAW; J.fo = (float*)(ws + 2 * SLOT); J.ss = (float*)(misc + OFF_SS); }
    else if (ph == 6) { J.A = (const bf16_t*)P.out; J.Bt = (const bf16_t*)(misc + OFF_WF1); J.M = MT; J.N = FFW; J.K = DM; J.mode = EPI_RELU2; J.o0 = (bf16_t*)(ws + 3 * SLOT); J.ldc = FFW; }
    else if (ph == 7) { J.A = (const bf16_t*)(ws + 3 * SLOT); J.Bt = (const bf16_t*)(misc + OFF_WF2); J.M = MT; J.N = DM; J.K = FFW; J.mode = EPI_RAW; J.fo = P.out; J.ss = (float*)(misc + OFF_SS) + MT; }
    else if (ph == 9 && g == 0) { J.A = (const bf16_t*)(misc + OFF_PB); J.Bt = (const bf16_t*)(misc + OFF_WP); J.M = MT; J.N = DM; J.K = PLED; J.mode = EPI_BF16; J.o0 = (bf16_t*)(ws + 3 * SLOT); }
    else { J.A = (const bf16_t*)(ws + 2 * SLOT); J.Bt = (const bf16_t*)(misc + OFF_WG); J.M = MT; J.N = DM; J.K = DM; J.mode = EPI_GATE; J.fo = (float*)(ws + 4 * SLOT); J.ss = (float*)(misc + OFF_SS) + 2 * MT;
           J.i0 = (const bf16_t*)(ws + 3 * SLOT); J.bias = P.in[23]; }
    return J;
}

__global__ void __launch_bounds__(512, 2) mega_fwd(Params P) {
    extern __shared__ __attribute__((aligned(16))) unsigned char lds_raw[];
    LAS unsigned char* lds = (LAS unsigned char*)lds_raw;
    cg::grid_group grid = cg::this_grid();
    const int G = gridDim.x;
    volatile LAS unsigned* stw = (volatile LAS unsigned*)(lds + 131072);
    if (threadIdx.x < 4) stw[threadIdx.x] = 0u;
    __syncthreads();
    const XcdBarrier xb = xcd_barrier_post((unsigned*)(P.ws + 7 * SLOT + OFF_BAR), stw);
    for (int ph = P.ph_lo; ph < P.ph_hi; ++ph) {
        if (ph > P.ph_lo) {
            if (P.ph_lo != 0) grid.sync();
            else xcd_barrier(xb);
        }
        int ngemm = 0;
        if (ph == 0) { if (PHMASK & 1) prologue(lds, P, G); }
        else if (ph == 2) { if (PHMASK & 2) gmlp_phase(lds, P, G); if (PHMASK & 4) attn_phase(lds, P, G); }
        else if (ph == 5) { if (PHMASK & 8) elementwise_phase(P, 0, G); }
        else if (ph == 8) { if (PHMASK & 8) elementwise_phase(P, 1, G); }
        else if (ph == 10) { if (PHMASK & 8) elementwise_phase(P, 2, G); }
        else ngemm = (ph == 1 || ph == 3 || ph == 9) ? 2 : 1;
        if (PHMASK & 16) for (int g = 0; g < ngemm; ++g) {
            const GemmJob J = make_job(P, ph, g);
            gemm_phase(lds, J, G, blockIdx.x);
        }
    }
}

extern "C" void kernel_launch(void* const* d_in, const int* in_sizes, int n_in, void* d_out, int out_size, void* d_ws, size_t ws_size, hipStream_t stream) {
    static int grid_blocks = 0;
    if (!grid_blocks) {
        int dev = 0, cus = 0, per_cu = 0;
        hipGetDevice(&dev);
        hipDeviceGetAttribute(&cus, hipDeviceAttributeMultiprocessorCount, dev);
        if (hipFuncSetAttribute((const void*)mega_fwd, hipFuncAttributeMaxDynamicSharedMemorySize, LDS_BYTES) != hipSuccess) fprintf(stderr, "hipFuncSetAttribute failed\n");
        hipOccupancyMaxActiveBlocksPerMultiprocessor(&per_cu, (const void*)mega_fwd, 512, LDS_BYTES);
        if (per_cu < 1) { fprintf(stderr, "occupancy query returned %d\n", per_cu); per_cu = 1; }
        grid_blocks = cus * per_cu;
        if (ws_size < 8 * SLOT) fprintf(stderr, "workspace too small: %zu\n", ws_size);
    }
    Params p{};
    for (int i = 0; i < 25; ++i) p.in[i] = (const float*)d_in[i];
    p.out = (float*)d_out; p.ws = (unsigned char*)d_ws; p.ph_lo = 0; p.ph_hi = NPHASE;
    if (hipMemsetAsync((char*)d_ws + 7 * SLOT + OFF_BAR, 0, 16384, stream) != hipSuccess) fprintf(stderr, "hipMemsetAsync of the barrier words failed\n");
    void* args[] = {&p};
    hipError_t e = hipLaunchCooperativeKernel((const void*)mega_fwd, dim3(grid_blocks), dim3(512), args, LDS_BYTES, stream);
    if (e != hipSuccess) fprintf(stderr, "cooperative launch failed: %s (grid %d)\n", hipGetErrorString(e), grid_blocks);
}
```
